# Optimizing an MI355X kernel written in HIP

```python
import jax, jax.numpy as jnp
from jax import lax
import numpy as np

D_MODEL = 1024
BATCH = 8
SEQ = 4096
DEPTH = 1

N_HEADS = 8
HEAD_DIM = 128
ATTN_WIDTH = N_HEADS * HEAD_DIM
Q_BLOCK = 128
LRU_WIDTH = 1536
LRU_BLOCKS = 12
LRU_BLOCK = LRU_WIDTH // LRU_BLOCKS
CONV_WIDTH = 4
LRU_C = 8.0
FFN_HIDDEN = -(-8 * D_MODEL // (3 * 256)) * 256
N_MOD = 6
EPS = 1e-6
IN_WIDTHS = (ATTN_WIDTH, ATTN_WIDTH, ATTN_WIDTH, LRU_WIDTH, LRU_WIDTH, D_MODEL, D_MODEL)
IN_TOTAL = sum(IN_WIDTHS)

kernel_name = "hybrid_stickbreak_rglru_block"


def rms_norm(x, g):
    xf = x.astype(jnp.float32)
    y = xf * lax.rsqrt(jnp.mean(xf * xf, axis=-1, keepdims=True) + EPS)
    return (y * g.astype(jnp.float32)).astype(x.dtype)


def stick_breaking_attention(q, k, v):
    S, Dh = q.shape[2], q.shape[3]
    scale = Dh ** -0.5
    outs = []
    for blk in range(S // Q_BLOCK):
        q0, q1 = blk * Q_BLOCK, (blk + 1) * Q_BLOCK
        qb = q[:, :, q0:q1]
        kb = k[:, :, :q1]
        vb = v[:, :, :q1]
        z = jnp.einsum('bhtd,bhsd->bhts', qb, kb).astype(jnp.float32) * scale
        t_idx = jnp.arange(q0, q1)[:, None]
        s_idx = jnp.arange(q1)[None, :]
        causal = s_idx < t_idx
        log_beta = jax.nn.log_sigmoid(z)
        log_one_minus = jnp.where(causal, jax.nn.log_sigmoid(-z), 0.0)
        rc = lax.cumsum(log_one_minus, axis=3, reverse=True)
        suffix = jnp.pad(rc[..., 1:], ((0, 0), (0, 0), (0, 0), (0, 1)))
        w = jnp.where(causal, jnp.exp(log_beta + suffix), 0.0)
        outs.append(jnp.einsum('bhts,bhsd->bhtd', w, vb.astype(jnp.float32)))
    return jnp.concatenate(outs, axis=2).astype(q.dtype)


def causal_depthwise_conv(x, w, b):
    S = x.shape[1]
    xp = jnp.pad(x, ((0, 0), (CONV_WIDTH - 1, 0), (0, 0)))
    y = b
    for kk in range(CONV_WIDTH):
        y = y + xp[:, kk:kk + S] * w[kk]
    return y


def block_diag_linear(x, w, b):
    Bsz, S, W = x.shape
    xb = x.reshape(Bsz, S, LRU_BLOCKS, LRU_BLOCK)
    return jnp.einsum('bsni,nij->bsnj', xb, w).reshape(Bsz, S, W) + b


def rg_lru(x, w_rg, b_rg, w_ig, b_ig, lam):
    r = jax.nn.sigmoid(block_diag_linear(x, w_rg, b_rg).astype(jnp.float32))
    i = jax.nn.sigmoid(block_diag_linear(x, w_ig, b_ig).astype(jnp.float32))
    log_a = -LRU_C * r * jax.nn.softplus(-lam.astype(jnp.float32))
    a = jnp.exp(log_a)
    mult = jnp.sqrt(-jnp.expm1(2.0 * log_a))
    u = mult * (i * x.astype(jnp.float32))

    def combine(left, right):
        a1, b1 = left
        a2, b2 = right
        return a1 * a2, a2 * b1 + b2

    _, h = lax.associative_scan(combine, (a, u), axis=1)
    return h.astype(x.dtype)


def setup_inputs(seed: int = 0) -> dict:
    key = jax.random.key(seed)
    ks = jax.random.split(key, 24)
    nrm = lambda k, shape, s: jax.random.normal(k, shape, jnp.float32) * s
    L, D = DEPTH, D_MODEL
    u = jax.random.uniform(ks[13], (L, LRU_WIDTH), jnp.float32, 0.9, 0.999)
    a0 = u ** (1.0 / LRU_C)
    lru_lambda = jnp.log(a0) - jnp.log1p(-a0)
    return {
        "x": nrm(ks[0], (BATCH, SEQ, D), 1.0),
        "c": nrm(ks[1], (BATCH, D), 1.0),
        "w_ada": nrm(ks[2], (L, D, N_MOD * D), 0.5 * D ** -0.5),
        "b_ada": nrm(ks[3], (L, N_MOD * D), 0.01),
        "norm1_g": 1.0 + nrm(ks[4], (L, D), 0.02),
        "w_in": nrm(ks[5], (L, D, IN_TOTAL), D ** -0.5),
        "q_norm_g": 1.0 + nrm(ks[6], (L, HEAD_DIM), 0.02),
        "k_norm_g": 1.0 + nrm(ks[7], (L, HEAD_DIM), 0.02),
        "conv_w": nrm(ks[8], (L, CONV_WIDTH, LRU_WIDTH), CONV_WIDTH ** -0.5),
        "conv_b": nrm(ks[9], (L, LRU_WIDTH), 0.01),
        "w_rg": nrm(ks[10], (L, LRU_BLOCKS, LRU_BLOCK, LRU_BLOCK), LRU_BLOCK ** -0.5),
        "b_rg": nrm(ks[11], (L, LRU_WIDTH), 0.01),
        "w_ig": nrm(ks[12], (L, LRU_BLOCKS, LRU_BLOCK, LRU_BLOCK), LRU_BLOCK ** -0.5),
        "b_ig": nrm(ks[14], (L, LRU_WIDTH), 0.01),
        "lru_lambda": lru_lambda,
        "w_proj_attn": nrm(ks[15], (L, ATTN_WIDTH, D), ATTN_WIDTH ** -0.5),
        "w_proj_lru": nrm(ks[16], (L, LRU_WIDTH, D), LRU_WIDTH ** -0.5),
        "w_out": nrm(ks[17], (L, D, D), D ** -0.5),
        "norm2_g": 1.0 + nrm(ks[18], (L, D), 0.02),
        "w_ffn_in": nrm(ks[19], (L, D, 2 * FFN_HIDDEN), D ** -0.5),
        "w_ffn_out": nrm(ks[20], (L, FFN_HIDDEN, D), FFN_HIDDEN ** -0.5),
    }


def reference(x, c, w_ada, b_ada, norm1_g, w_in, q_norm_g, k_norm_g, conv_w, conv_b,
              w_rg, b_rg, w_ig, b_ig, lru_lambda, w_proj_attn, w_proj_lru, w_out,
              norm2_g, w_ffn_in, w_ffn_out):
    Bsz, S, D = x.shape
    split_at = [int(v) for v in np.cumsum(IN_WIDTHS)[:-1]]
    c_act = jax.nn.silu(c)
    for l in range(DEPTH):
        mod = jnp.einsum('bd,de->be', c_act, w_ada[l]) + b_ada[l]
        shift1, scale1, gate1, shift2, scale2, gate2 = [
            m[:, None, :] for m in jnp.split(mod, N_MOD, axis=-1)]

        h = rms_norm(x, norm1_g[l]) * (1.0 + scale1) + shift1
        proj = jnp.einsum('bsd,de->bse', h, w_in[l])
        q, k, v, xr, gr, ga, gb = jnp.split(proj, split_at, axis=-1)

        q = rms_norm(q.reshape(Bsz, S, N_HEADS, HEAD_DIM), q_norm_g[l])
        k = rms_norm(k.reshape(Bsz, S, N_HEADS, HEAD_DIM), k_norm_g[l])
        v = v.reshape(Bsz, S, N_HEADS, HEAD_DIM)
        o = stick_breaking_attention(q.transpose(0, 2, 1, 3), k.transpose(0, 2, 1, 3),
                                     v.transpose(0, 2, 1, 3))
        o = o.transpose(0, 2, 1, 3).reshape(Bsz, S, ATTN_WIDTH)
        p_attn = jnp.einsum('bsa,ad->bsd', o, w_proj_attn[l])

        xc = causal_depthwise_conv(xr, conv_w[l], conv_b[l])
        y_lru = rg_lru(xc, w_rg[l], b_rg[l], w_ig[l], b_ig[l], lru_lambda[l])
        y_lru = jax.nn.gelu(gr) * y_lru
        p_lru = jnp.einsum('bsw,wd->bsd', y_lru, w_proj_lru[l])

        merged = jax.nn.sigmoid(ga) * p_attn + jax.nn.sigmoid(gb) * p_lru
        mix_out = jnp.einsum('bsd,de->bse', merged, w_out[l])
        x = x + gate1 * mix_out

        h2 = rms_norm(x, norm2_g[l]) * (1.0 + scale2) + shift2
        gu = jnp.einsum('bsd,df->bsf', h2, w_ffn_in[l])
        g_ffn, u_ffn = jnp.split(gu, 2, axis=-1)
        ffn_out = jnp.einsum('bsf,fd->bsd', jax.nn.silu(g_ffn) * u_ffn, w_ffn_out[l])
        x = x + gate2 * ffn_out
    return x
```

```cpp
#include <hip/hip_runtime.h>
#include <hip/hip_cooperative_groups.h>
#include <cstdio>
namespace cg = cooperative_groups;

#ifndef MK_PER_PHASE
#define MK_PER_PHASE 0
#endif

#define LAS __attribute__((address_space(3)))
typedef float f32x2 __attribute__((ext_vector_type(2)));
typedef float f32x16 __attribute__((ext_vector_type(16)));
typedef __bf16 bf16x2_t __attribute__((ext_vector_type(2)));
typedef short s16x4 __attribute__((ext_vector_type(4)));
typedef unsigned u32x2 __attribute__((ext_vector_type(2)));

constexpr int D_ = 1024, NB = 8, SEQ_ = 4096, MTOK = NB * SEQ_, NH = 8, DH = 128, LW = 1536, FFH = 2816, NIN = 8192;
constexpr float EPS_ = 1e-6f;
constexpr size_t MIB = 1048576;
constexpr int CATLD = 2560;
constexpr size_t WS_CAT = 0, WS_K = 160 * MIB, WS_V = 224 * MIB, WS_XR = 288 * MIB, WS_H = 384 * MIB;
constexpr size_t WS_WIN = 448 * MIB, WS_WCAT = 464 * MIB, WS_WOUT = 469 * MIB, WS_WF1 = 471 * MIB, WS_WF2 = 482 * MIB;
constexpr size_t WS_MOD = 488 * MIB, WS_CTL = 489 * MIB, WS_END = 489 * MIB + 32768;
constexpr size_t WS_MERGED = WS_K, WS_ACT = 0;
constexpr int LDS_BYTES = 8 * 18944 + 64;
constexpr int NPHASE = 9;
constexpr bool GEMM_ALIGN = true, GEMM_SP2 = true;
constexpr int STAG_G1 = 0, STAG_G5 = 0;

__device__ __forceinline__ unsigned pk2(float a, float b) { f32x2 v = {a, b}; bf16x2_t r = __builtin_convertvector(v, bf16x2_t); return __builtin_bit_cast(unsigned, r); }
__device__ __forceinline__ float bf_lo(unsigned w) { return __uint_as_float(w << 16); }
__device__ __forceinline__ float bf_hi(unsigned w) { return __uint_as_float(w & 0xffff0000u); }
__device__ __forceinline__ float bf1(unsigned short w) { return __uint_as_float(((unsigned)w) << 16); }
__device__ __forceinline__ float fast_sigmoid(float x) { return __builtin_amdgcn_rcpf(1.0f + __expf(-x)); }
__device__ __forceinline__ float gelu_tanh(float x) { const float t = 1.5957691216057308f * (x + 0.044715f * x * x * x); return x * fast_sigmoid(t); }
#define LDS_WAIT() asm volatile("s_waitcnt lgkmcnt(0)" ::: "memory")
#define ST_EPI(last_, val_, ptr_) do { if (last_) __builtin_nontemporal_store((val_), (ptr_)); else *(ptr_) = (val_); } while (0)
__device__ __forceinline__ float xor32(float v) {
    const unsigned u = __float_as_uint(v);
    auto r = __builtin_amdgcn_permlane32_swap(u, u, false, false);
    return __uint_as_float((threadIdx.x & 32) ? (unsigned)r[0] : (unsigned)r[1]);
}

namespace pg8 {
#define PG8_LAS __attribute__((address_space(3)))
typedef unsigned short bf16_t;
typedef short bf16x8 __attribute__((ext_vector_type(8)));
typedef float f32x4 __attribute__((ext_vector_type(4)));
typedef unsigned u32x4 __attribute__((ext_vector_type(4)));
constexpr int BM = 256, BK = 64, HALF = 128, HTB = HALF * BK * 2  , STAGE_BYTES = 8 * HTB, NXCD = 8, WGM = 8;

__host__ __device__ __forceinline__ int lds_byte(int r, int c) { const int st = (r >> 4) * 2 + (c >> 5), rr = r & 15, cc = c & 31, ob = rr * 64 + cc * 2; return st * 1024 + (ob ^ (((ob >> 9) & 1) << 5)); }
__host__ __device__ __forceinline__ void stage_rc(int b, int& R, int& C) { const int st = b / 1024, sb = b % 1024, swz = sb ^ (((sb >> 9) & 1) << 5); R = (st >> 1) * 16 + swz / 64; C = (st & 1) * 32 + (swz % 64) / 2; }
__host__ __device__ __forceinline__ int perm32(int rho) { const int n = rho >> 4, i = rho & 15; return 8 * (i >> 2) + 4 * n + (i & 3); }

struct Unit { int pm, pn, last; };
struct Gemm { const bf16_t* A; const bf16_t* Bt; int M, N, K; };

struct StaticOrder {
    int nM, nN, nwg, G, c;
    __host__ __device__ void init(int M, int N, int G_, int c_) { nM = M / BM; nN = N / BM; nwg = nM * nN; G = G_; c = c_; }
    __host__ __device__ bool next(int i, Unit& u) const {
        const long L = (long)i * G + c; if (L >= nwg) return false;
        int wgid = (int)L; { const int q = nwg / NXCD, r = nwg % NXCD, xcd = wgid % NXCD, off = wgid / NXCD; wgid = (xcd < r ? xcd * (q + 1) : r * (q + 1) + (xcd - r) * q) + off; }
        const int nig = WGM * nN, gid = wgid / nig, fm = gid * WGM, gsz = (nM - fm) < WGM ? (nM - fm) : WGM;
        u.pm = fm + ((wgid % nig) % gsz); u.pn = (wgid % nig) / gsz; return true;
    }
    __device__ __forceinline__ void a_ready(const Unit&) const {}
    __device__ __forceinline__ void done(const Unit&) const {}
};
template <class Epi, class Sched, bool ALIGN_EPI = false, bool SP2 = false>
__device__ __forceinline__ void gemm_phase(PG8_LAS unsigned char* lds, const Gemm g, const Sched& S, const Epi& E) {
    int tid_ = threadIdx.x; asm volatile("" : "+v"(tid_));
    const int tid = tid_, wid = __builtin_amdgcn_readfirstlane(tid >> 6), lane = tid & 63, wr = wid >> 2, wc = wid & 3, fr = lane & 15, fq = lane >> 4;
    const int K = g.K, nt = K / BK;
    unsigned voffA[2], voffB[2];
#pragma unroll
    for (int i = 0; i < 2; ++i) { int R, C; stage_rc(tid * 16 + i * 8192, R, C); const int Rb = Epi::PERM ? ((R & ~31) + perm32(R & 31)) : R;
        voffA[i] = (unsigned)(R * K + C) * 2u; voffB[i] = (unsigned)(Rb * K + C) * 2u; }
    const size_t kstep = (size_t)(BK * 2);
    const size_t hstep = (size_t)HALF * K * 2;
    const size_t tstep = 2 * hstep;
    const unsigned ldsw = (unsigned)wid * 1024u;
    const int aoff = lds_byte(wr * 64 + fr, fq * 8), boff = lds_byte(wc * 32 + fr, fq * 8);
#define PG8_SA(b, h) (((b) * 2 + (h)) * HTB)
#define PG8_SB(b, h) ((4 + (b) * 2 + (h)) * HTB)
#define PG8_STAGE(bufoff, gbase, voff) do { _Pragma("unroll") for (int _i = 0; _i < 2; ++_i) \
        __builtin_amdgcn_global_load_lds((const unsigned*)((const char*)(gbase) + (voff)[_i]), (PG8_LAS unsigned*)(lds + (bufoff) + ldsw + _i * 8192), 16, 0, 0); } while (0)
#define PG8_LDA(dst, b, h) do { _Pragma("unroll") for (int m = 0; m < 4; ++m) _Pragma("unroll") for (int k = 0; k < 2; ++k) dst[m][k] = *(const PG8_LAS bf16x8*)(lds + PG8_SA(b, h) + aoff + m * 2048 + k * 1024); } while (0)
#define PG8_LDB(dst, b, h) do { _Pragma("unroll") for (int n = 0; n < 2; ++n) _Pragma("unroll") for (int k = 0; k < 2; ++k) dst[n][k] = *(const PG8_LAS bf16x8*)(lds + PG8_SB(b, h) + boff + n * 2048 + k * 1024); } while (0)
#define PG8_MMA(ai, bj, At, Bt) do { __builtin_amdgcn_s_setprio(1); _Pragma("unroll") for (int m = 0; m < 4; ++m) _Pragma("unroll") for (int n = 0; n < 2; ++n) _Pragma("unroll") for (int k = 0; k < 2; ++k) \
        acc[ai][bj][m][n] = __builtin_amdgcn_mfma_f32_16x16x32_bf16(Bt[n][k], At[m][k], acc[ai][bj][m][n], 0, 0, 0); __builtin_amdgcn_s_setprio(0); } while (0)
#define PG8_WAIT_V(n) asm volatile("s_waitcnt vmcnt(" #n ")" ::: "memory")
#define PG8_WAIT_L(n) asm volatile("s_waitcnt lgkmcnt(" #n ")" ::: "memory")
#define PG8_BAR __builtin_amdgcn_s_barrier()
#define PG8_SCHED __builtin_amdgcn_sched_barrier(0)
    Unit cur, nxt; int ui = 0;
    if (!S.next(0, cur)) return;
    f32x4 acc[2][2][4][2];
#pragma unroll
    for (int a = 0; a < 2; ++a)
#pragma unroll
        for (int b = 0; b < 2; ++b)
#pragma unroll
            for (int m = 0; m < 4; ++m)
#pragma unroll
                for (int n = 0; n < 2; ++n) acc[a][b][m][n] = (f32x4){0.f, 0.f, 0.f, 0.f};
    bf16x8 At[4][2], B0[2][2], B1[2][2];
    const char* cA = (const char*)g.A + (size_t)cur.pm * tstep; const char* cB = (const char*)g.Bt + (size_t)cur.pn * tstep;
    S.a_ready(cur);
    if constexpr (SP2) {
        PG8_STAGE(PG8_SB(0, 0), cB, voffB); PG8_STAGE(PG8_SB(0, 1), cB + hstep, voffB); PG8_STAGE(PG8_SA(0, 0), cA, voffA); PG8_STAGE(PG8_SA(0, 1), cA + hstep, voffA);
        if (wr == 1) PG8_BAR;
        PG8_WAIT_V(2); PG8_BAR;
        PG8_STAGE(PG8_SB(1, 0), cB + kstep, voffB); PG8_STAGE(PG8_SA(1, 0), cA + kstep, voffA); PG8_STAGE(PG8_SB(1, 1), cB + hstep + kstep, voffB);
        PG8_WAIT_V(6); PG8_BAR;
    } else {
        PG8_STAGE(PG8_SB(0, 0), cB, voffB); PG8_STAGE(PG8_SA(0, 0), cA, voffA); PG8_STAGE(PG8_SB(0, 1), cB + hstep, voffB); PG8_STAGE(PG8_SA(0, 1), cA + hstep, voffA);
        if (wr == 1) PG8_BAR;
        PG8_WAIT_V(4); PG8_BAR;
        PG8_STAGE(PG8_SB(1, 0), cB + kstep, voffB); PG8_STAGE(PG8_SA(1, 0), cA + kstep, voffA); PG8_STAGE(PG8_SB(1, 1), cB + hstep + kstep, voffB);
        PG8_WAIT_V(6); PG8_BAR;
    }
    for (;;) {
        const bool has_next = S.next(ui + 1, nxt);
        const char* nA = has_next ? (const char*)g.A + (size_t)nxt.pm * tstep : cA; const char* nB = has_next ? (const char*)g.Bt + (size_t)nxt.pn * tstep : cB;
        for (int t = 0; t < nt; t += 2) {
            const bool last = (t == nt - 2);
            const char* a1 = cA + (size_t)(t + 1) * kstep;
            const char* a2 = last ? nA : cA + (size_t)(t + 2) * kstep; const char* b2 = last ? nB : cB + (size_t)(t + 2) * kstep;
            const char* a3 = a2 + kstep; const char* b3 = b2 + kstep;
            if (last && has_next) S.a_ready(nxt);
            if constexpr (Epi::MID_T >= 0) { if (t == Epi::MID_T) E.mid(acc, cur, wr, wc, fr, fq); }
            if constexpr (SP2) {
            PG8_LDB(B0, 0, 0); PG8_LDB(B1, 0, 1); PG8_SCHED; PG8_LDA(At, 0, 0); PG8_STAGE(PG8_SA(1, 1), a1 + hstep, voffA);
            PG8_WAIT_V(8); PG8_WAIT_L(0); PG8_BAR; PG8_MMA(0, 0, At, B0); PG8_MMA(0, 1, At, B1); PG8_BAR; PG8_SCHED;
            PG8_LDA(At, 0, 1); PG8_STAGE(PG8_SB(0, 0), b2, voffB); PG8_STAGE(PG8_SB(0, 1), b2 + hstep, voffB); PG8_STAGE(PG8_SA(0, 0), a2, voffA);
            PG8_WAIT_V(8); PG8_WAIT_L(0); PG8_BAR; PG8_MMA(1, 0, At, B0); PG8_MMA(1, 1, At, B1); PG8_BAR; PG8_SCHED;
            PG8_LDB(B0, 1, 0); PG8_LDB(B1, 1, 1); PG8_SCHED; PG8_LDA(At, 1, 0); PG8_STAGE(PG8_SA(0, 1), a2 + hstep, voffA);
            PG8_WAIT_V(8); PG8_WAIT_L(0); PG8_BAR; PG8_MMA(0, 0, At, B0); PG8_MMA(0, 1, At, B1); PG8_BAR; PG8_SCHED;
            PG8_LDA(At, 1, 1); PG8_STAGE(PG8_SB(1, 0), b3, voffB); PG8_STAGE(PG8_SB(1, 1), b3 + hstep, voffB); PG8_STAGE(PG8_SA(1, 0), a3, voffA);
            PG8_WAIT_V(8); PG8_WAIT_L(0); PG8_BAR; PG8_MMA(1, 0, At, B0); PG8_MMA(1, 1, At, B1); PG8_BAR; PG8_SCHED;
            } else {
            PG8_LDB(B0, 0, 0); PG8_SCHED; PG8_LDA(At, 0, 0); PG8_STAGE(PG8_SA(1, 1), a1 + hstep, voffA);
            PG8_WAIT_L(8); PG8_BAR; PG8_WAIT_L(0); PG8_MMA(0, 0, At, B0); PG8_BAR; PG8_SCHED;
            PG8_LDB(B1, 0, 1); PG8_STAGE(PG8_SB(0, 0), b2, voffB);
            PG8_BAR; PG8_WAIT_L(0); PG8_MMA(0, 1, At, B1); PG8_BAR;
            PG8_LDA(At, 0, 1); PG8_STAGE(PG8_SA(0, 0), a2, voffA);
            PG8_BAR; PG8_WAIT_L(0); PG8_MMA(1, 0, At, B0); PG8_BAR; PG8_SCHED;
            PG8_STAGE(PG8_SB(0, 1), b2 + hstep, voffB);
            PG8_WAIT_V(6); PG8_BAR; PG8_MMA(1, 1, At, B1); PG8_BAR;
            PG8_LDB(B0, 1, 0); PG8_SCHED; PG8_LDA(At, 1, 0); PG8_STAGE(PG8_SA(0, 1), a2 + hstep, voffA);
            PG8_WAIT_L(8); PG8_BAR; PG8_WAIT_L(0); PG8_MMA(0, 0, At, B0); PG8_BAR; PG8_SCHED;
            PG8_LDB(B1, 1, 1); PG8_STAGE(PG8_SB(1, 0), b3, voffB);
            PG8_BAR; PG8_WAIT_L(0); PG8_MMA(0, 1, At, B1); PG8_BAR;
            PG8_LDA(At, 1, 1); PG8_STAGE(PG8_SA(1, 0), a3, voffA);
            PG8_BAR; PG8_WAIT_L(0); PG8_MMA(1, 0, At, B0); PG8_BAR; PG8_SCHED;
            PG8_STAGE(PG8_SB(1, 1), b3 + hstep, voffB);
            PG8_WAIT_V(6); PG8_BAR; PG8_MMA(1, 1, At, B1); PG8_BAR;
            }
        }
        if constexpr (ALIGN_EPI) { if (wr == 0) PG8_BAR; }
        cur.last = has_next ? 0 : 1;
        if constexpr (!Epi::AFTER_DRAIN) { E(acc, cur, wr, wc, fr, fq); S.done(cur); }
        if (!has_next) break;
#pragma unroll
        for (int a = 0; a < 2; ++a)
#pragma unroll
            for (int b = 0; b < 2; ++b)
#pragma unroll
                for (int m = 0; m < 4; ++m)
#pragma unroll
                    for (int n = 0; n < 2; ++n) acc[a][b][m][n] = (f32x4){0.f, 0.f, 0.f, 0.f};
        cur = nxt; cA = nA; cB = nB; ++ui;
        if constexpr (ALIGN_EPI) { if (wr == 1) PG8_BAR; }
    }
    PG8_WAIT_V(0);
    if constexpr (!ALIGN_EPI) { if (wr == 0) PG8_BAR; }
    PG8_BAR;
    if constexpr (Epi::AFTER_DRAIN) { E.fused(acc, cur, wr, wc, fr, fq, lds, wid, lane); S.done(cur); }
#undef PG8_SA
#undef PG8_SB
#undef PG8_STAGE
#undef PG8_LDA
#undef PG8_LDB
#undef PG8_MMA
#undef PG8_WAIT_V
#undef PG8_WAIT_L
#undef PG8_BAR
#undef PG8_SCHED
}
}

using pg8::bf16_t; using pg8::bf16x8; using pg8::f32x4; using pg8::u32x4; using pg8::Unit;
#define MFMA32(a, b, c) __builtin_amdgcn_mfma_f32_32x32x16_bf16((a), (b), (c), 0, 0, 0)

template <int ACT> __device__ __forceinline__ float act_f(float x) { return ACT == 1 ? gelu_tanh(x) : (ACT == 2 ? fast_sigmoid(x) : x); }
template <int ACT> __device__ __forceinline__ void store_tile_bf16(const f32x4 (&acc)[2][2][4][2], bf16_t* dst, int ld, int row0, int col0, int last) {
#pragma unroll
    for (int ai = 0; ai < 2; ++ai)
#pragma unroll
        for (int m = 0; m < 4; ++m) { bf16_t* rowp = dst + (size_t)(row0 + ai * 128 + m * 16) * ld + col0;
#pragma unroll
            for (int bj = 0; bj < 2; ++bj) { const f32x4 v0 = acc[ai][bj][m][0], v1 = acc[ai][bj][m][1]; u32x4 w;
                w.x = pk2(act_f<ACT>(v0[0]), act_f<ACT>(v0[1])); w.y = pk2(act_f<ACT>(v0[2]), act_f<ACT>(v0[3]));
                w.z = pk2(act_f<ACT>(v1[0]), act_f<ACT>(v1[1])); w.w = pk2(act_f<ACT>(v1[2]), act_f<ACT>(v1[3]));
                ST_EPI(last, w, (u32x4*)(rowp + bj * 128)); } asm volatile("" ::: "memory"); }
}
struct EpiIn {
    static constexpr bool PERM = true, AFTER_DRAIN = false; static constexpr int MID_T = -1;
    bf16_t *cat, *k, *v, *xr, *sga, *sgb; const float *qg, *kg; LAS float* P;
    __device__ __forceinline__ void operator()(const f32x4 (&acc)[2][2][4][2], const Unit& u, int wr, int wc, int fr, int fq) const {
        const int pn = u.pn, row0 = u.pm * 256 + wr * 64 + fr, colw = wc * 32 + 8 * fq;
        if (pn < 8) {
            const bool isq = pn < 4; bf16_t* dst = isq ? cat : k; const float* gw = isq ? qg : kg; const int colt = (pn & 3) * 256, ldq = isq ? CATLD : 1024;
            const int pbase = wr * 1024 + fr * 4;
#pragma unroll
            for (int ai = 0; ai < 2; ++ai)
#pragma unroll
                for (int bj = 0; bj < 2; ++bj)
#pragma unroll
                    for (int m = 0; m < 4; ++m) { const f32x4 a0 = acc[ai][bj][m][0], a1 = acc[ai][bj][m][1];
                        float s = (a0[0] * a0[0] + a0[1] * a0[1]) + (a0[2] * a0[2] + a0[3] * a0[3]) + (a1[0] * a1[0] + a1[1] * a1[1]) + (a1[2] * a1[2] + a1[3] * a1[3]);
                        s += __shfl_xor(s, 16); s += __shfl_xor(s, 32);
                        if (fq == 0) P[pbase + ((ai * 2 + bj) * 4 + m) * 64 + wc] = s; }
            LDS_WAIT(); __builtin_amdgcn_s_barrier(); asm volatile("" ::: "memory");
            const f32x4 g0 = *(const f32x4*)(gw + colw), g1 = *(const f32x4*)(gw + colw + 4);
            const float sc = isq ? 0.12751743f : 1.0f;
#pragma unroll
            for (int ai = 0; ai < 2; ++ai)
#pragma unroll
                for (int m = 0; m < 4; ++m) { bf16_t* rowp = dst + (size_t)(row0 + ai * 128 + m * 16) * ldq + colt + colw;
#pragma unroll
                    for (int bj = 0; bj < 2; ++bj) { const f32x4 p = *(const LAS f32x4*)(P + pbase + ((ai * 2 + bj) * 4 + m) * 64);
                        const float rs = rsqrtf(((p[0] + p[1]) + (p[2] + p[3])) * (1.0f / 128.0f) + EPS_) * sc;
                        const f32x4 v0 = acc[ai][bj][m][0] * rs * g0, v1 = acc[ai][bj][m][1] * rs * g1; u32x4 w;
                        w.x = pk2(v0[0], v0[1]); w.y = pk2(v0[2], v0[3]); w.z = pk2(v1[0], v1[1]); w.w = pk2(v1[2], v1[3]);
                        ST_EPI(u.last, w, (u32x4*)(rowp + bj * 128)); } asm volatile("" ::: "memory"); }
        }
        else if (pn < 12) store_tile_bf16<0>(acc, v, 1024, row0, (pn - 8) * 256 + colw, u.last);
        else if (pn < 18) store_tile_bf16<0>(acc, xr, LW, row0, (pn - 12) * 256 + colw, u.last);
        else if (pn < 24) store_tile_bf16<1>(acc, cat, CATLD, row0, 1024 + (pn - 18) * 256 + colw, u.last);
        else if (pn < 28) store_tile_bf16<2>(acc, sga, 1024, row0, (pn - 24) * 256 + colw, u.last);
        else store_tile_bf16<2>(acc, sgb, 1024, row0, (pn - 28) * 256 + colw, u.last);
    }
};
struct EpiMerge {
    static constexpr bool PERM = true, AFTER_DRAIN = false; static constexpr int MID_T = 16;
    const bf16_t* sga; const bf16_t* sgb; bf16_t* dst;
    static __device__ __forceinline__ float rc(float x) { return __builtin_amdgcn_rcpf(fmaxf(x, 1e-18f)); }
    static __device__ __forceinline__ float cl(float x) { return fmaxf(x, 1e-18f); }
    __device__ __forceinline__ void mid(f32x4 (&acc)[2][2][4][2], const Unit& u, int wr, int wc, int fr, int fq) const {
        int fr_ = fr; asm volatile("" : "+v"(fr_));
        const int row0 = u.pm * 256 + wr * 64 + fr_, col0 = u.pn * 256 + wc * 32 + 8 * fq;
#pragma unroll
        for (int ai = 0; ai < 2; ++ai)
#pragma unroll
            for (int mp = 0; mp < 2; ++mp) { u32x4 ga[2][2], gb[2][2];
#pragma unroll
                for (int mm = 0; mm < 2; ++mm)
#pragma unroll
                    for (int bj = 0; bj < 2; ++bj) { const size_t off = (size_t)(row0 + ai * 128 + (2 * mp + mm) * 16) * 1024 + col0 + bj * 128; ga[mm][bj] = __builtin_nontemporal_load((const u32x4*)(sga + off)); gb[mm][bj] = *(const u32x4*)(sgb + off); }
#pragma unroll
                for (int mm = 0; mm < 2; ++mm)
#pragma unroll
                    for (int bj = 0; bj < 2; ++bj) { const u32x4 a_ = ga[mm][bj], b_ = gb[mm][bj]; f32x4 r0, r1;
                        r0[0] = bf_lo(a_.x) * rc(bf_lo(b_.x)); r0[1] = bf_hi(a_.x) * rc(bf_hi(b_.x)); r0[2] = bf_lo(a_.y) * rc(bf_lo(b_.y)); r0[3] = bf_hi(a_.y) * rc(bf_hi(b_.y));
                        r1[0] = bf_lo(a_.z) * rc(bf_lo(b_.z)); r1[1] = bf_hi(a_.z) * rc(bf_hi(b_.z)); r1[2] = bf_lo(a_.w) * rc(bf_lo(b_.w)); r1[3] = bf_hi(a_.w) * rc(bf_hi(b_.w));
                        acc[ai][bj][2 * mp + mm][0] *= r0; acc[ai][bj][2 * mp + mm][1] *= r1; }
                asm volatile("" ::: "memory"); }
    }
    __device__ __forceinline__ void operator()(const f32x4 (&acc)[2][2][4][2], const Unit& u, int wr, int wc, int fr, int fq) const {
        const int row0 = u.pm * 256 + wr * 64 + fr, col0 = u.pn * 256 + wc * 32 + 8 * fq;
#pragma unroll
        for (int ai = 0; ai < 2; ++ai) { u32x4 g[4][2];
#pragma unroll
            for (int m = 0; m < 4; ++m)
#pragma unroll
                for (int bj = 0; bj < 2; ++bj) g[m][bj] = __builtin_nontemporal_load((const u32x4*)(sgb + (size_t)(row0 + ai * 128 + m * 16) * 1024 + col0 + bj * 128));
#pragma unroll
            for (int m = 0; m < 4; ++m)
#pragma unroll
                for (int bj = 0; bj < 2; ++bj) { const u32x4 b_ = g[m][bj]; const f32x4 v0 = acc[ai][bj][m][0], v1 = acc[ai][bj][m][1];
                    u32x4 w; w.x = pk2(cl(bf_lo(b_.x)) * v0[0], cl(bf_hi(b_.x)) * v0[1]); w.y = pk2(cl(bf_lo(b_.y)) * v0[2], cl(bf_hi(b_.y)) * v0[3]);
                    w.z = pk2(cl(bf_lo(b_.z)) * v1[0], cl(bf_hi(b_.z)) * v1[1]); w.w = pk2(cl(bf_lo(b_.w)) * v1[2], cl(bf_hi(b_.w)) * v1[3]);
                    *(u32x4*)(dst + (size_t)(row0 + ai * 128 + m * 16) * 1024 + col0 + bj * 128) = w; }
            asm volatile("" ::: "memory"); }
    }
};
struct EpiResid {
    static constexpr bool PERM = false, AFTER_DRAIN = false; static constexpr int MID_T = -1;
    const float* base; float* out; const float* gate;
    __device__ __forceinline__ void operator()(const f32x4 (&acc)[2][2][4][2], const Unit& u, int wr, int wc, int fr, int fq) const {
        const int row0 = u.pm * 256 + wr * 64 + fr, col0 = u.pn * 256 + wc * 32 + 4 * fq; const float* gp = gate + (size_t)(u.pm >> 4) * 6144 + col0;
        f32x4 gv[2][2];
#pragma unroll
        for (int bj = 0; bj < 2; ++bj)
#pragma unroll
            for (int n = 0; n < 2; ++n) gv[bj][n] = *(const f32x4*)(gp + bj * 128 + n * 16);
#pragma unroll
        for (int ai = 0; ai < 2; ++ai)
#pragma unroll
            for (int mp = 0; mp < 2; ++mp) { f32x4 bs[2][2][2];
#pragma unroll
                for (int mm = 0; mm < 2; ++mm)
#pragma unroll
                    for (int bj = 0; bj < 2; ++bj)
#pragma unroll
                        for (int n = 0; n < 2; ++n) bs[mm][bj][n] = __builtin_nontemporal_load((const f32x4*)(base + (size_t)(row0 + ai * 128 + (2 * mp + mm) * 16) * 1024 + col0 + bj * 128 + n * 16));
#pragma unroll
                for (int mm = 0; mm < 2; ++mm)
#pragma unroll
                    for (int bj = 0; bj < 2; ++bj)
#pragma unroll
                        for (int n = 0; n < 2; ++n) { const f32x4 o_ = bs[mm][bj][n] + gv[bj][n] * acc[ai][bj][2 * mp + mm][n]; ST_EPI(u.last, o_, (f32x4*)(out + (size_t)(row0 + ai * 128 + (2 * mp + mm) * 16) * 1024 + col0 + bj * 128 + n * 16)); }
                asm volatile("" ::: "memory"); }
    }
};
struct EpiSwiglu {
    static constexpr bool PERM = true, AFTER_DRAIN = false; static constexpr int MID_T = -1;
    bf16_t* act;
    __device__ __forceinline__ void operator()(const f32x4 (&acc)[2][2][4][2], const Unit& u, int wr, int wc, int fr, int fq) const {
        const int row0 = u.pm * 256 + wr * 64 + fr, col0 = u.pn * 128 + wc * 32 + 8 * fq;
#pragma unroll
        for (int ai = 0; ai < 2; ++ai)
#pragma unroll
            for (int m = 0; m < 4; ++m) { float r[8];
#pragma unroll
                for (int n = 0; n < 2; ++n)
#pragma unroll
                    for (int j = 0; j < 4; ++j) { const float g = acc[ai][0][m][n][j], uu = acc[ai][1][m][n][j]; r[4 * n + j] = g * fast_sigmoid(g) * uu; }
                u32x4 w; w.x = pk2(r[0], r[1]); w.y = pk2(r[2], r[3]); w.z = pk2(r[4], r[5]); w.w = pk2(r[6], r[7]);
                *(u32x4*)(act + (size_t)(row0 + ai * 128 + m * 16) * FFH + col0) = w; }
    }
};

__device__ __forceinline__ float wave_sum(float v) {
#pragma unroll
    for (int o = 1; o < 64; o <<= 1) v += __shfl_xor(v, o);
    return v;
}
template <bool FFN> __device__ __forceinline__ void transpose_item(const float* W, int K, int N, bf16_t* WT, int ldd, int koff, LAS float* scr, int item, int lane) {
    const int nblk = N / 32, kb = item / nblk, nb = item % nblk, k0 = 64 * kb, n0 = 32 * nb;
#pragma unroll
    for (int i = 0; i < 32; ++i) { const int kk = 2 * i + (lane >> 5); scr[kk * 33 + (lane & 31)] = W[(size_t)(k0 + kk) * N + n0 + (lane & 31)]; }
    LDS_WAIT();
    const int c = lane & 7;
#pragma unroll
    for (int j = 0; j < 4; ++j) { const int n = (lane >> 3) + 8 * j; const LAS float* s = scr + (8 * c) * 33 + n;
        u32x4 o; o.x = pk2(s[0 * 33], s[1 * 33]); o.y = pk2(s[2 * 33], s[3 * 33]); o.z = pk2(s[4 * 33], s[5 * 33]); o.w = pk2(s[6 * 33], s[7 * 33]);
        int row = n0 + n;
        if (FFN) { const int isu = row >= FFH ? 1 : 0, hid = row - isu * FFH; row = (hid >> 7) * 256 + isu * 128 + (hid & 127); }
        *(u32x4*)(WT + (size_t)row * ldd + koff + k0 + 8 * c) = o; }
    LDS_WAIT();
}
__device__ __forceinline__ void adaln_item(const float* c, const float* w_ada, const float* b_ada, float* mod, int item, LAS unsigned char* lds, int tid) {
    LAS float* cact = (LAS float*)lds;
    LAS float* red = (LAS float*)(lds + 32768);
    for (int i = tid; i < 8192; i += 512) { const int b = i >> 10, k = i & 1023; const float x = c[i]; cact[k * 8 + b] = x / (1.0f + expf(-x)); }
    __syncthreads();
    const int col = tid & 31, ks = tid >> 5, n = item * 32 + col;
    float acc[8];
#pragma unroll
    for (int b = 0; b < 8; ++b) acc[b] = 0.f;
#pragma unroll 32
    for (int kk = 0; kk < 64; ++kk) { const int k = ks * 64 + kk; const float w = w_ada[(size_t)k * 6144 + n];
        const f32x4 c0 = *(const LAS f32x4*)(cact + k * 8), c1 = *(const LAS f32x4*)(cact + k * 8 + 4);
        acc[0] += c0[0] * w; acc[1] += c0[1] * w; acc[2] += c0[2] * w; acc[3] += c0[3] * w; acc[4] += c1[0] * w; acc[5] += c1[1] * w; acc[6] += c1[2] * w; acc[7] += c1[3] * w; }
#pragma unroll
    for (int b = 0; b < 8; ++b) red[(ks * 8 + b) * 32 + col] = acc[b];
    __syncthreads();
    if (tid < 256) { const int b = tid >> 5, cc = tid & 31; float s = 0.f;
#pragma unroll
        for (int k2 = 0; k2 < 16; ++k2) s += red[(k2 * 8 + b) * 32 + cc];
        mod[b * 6144 + item * 32 + cc] = s + b_ada[item * 32 + cc]; }
    __syncthreads();
}
__device__ __forceinline__ void norm_rows(const float* src, const float* g, const float* shift, const float* scale, bf16_t* dst, int gw, int ngw, int lane) {
    f32x4 gv[4];
#pragma unroll
    for (int j = 0; j < 4; ++j) gv[j] = *((const f32x4*)g + 64 * j + lane);
    f32x4 v[4];
    if (gw < MTOK) {
#pragma unroll
        for (int j = 0; j < 4; ++j) v[j] = __builtin_nontemporal_load((const f32x4*)(src + (size_t)gw * D_) + lane + 64 * j);
    }
    for (int m = gw; m < MTOK; m += ngw) {
        const int b = m >> 12, mn = (m + ngw < MTOK) ? m + ngw : m;
        f32x4 vn[4], scv[4], shv[4];
        const f32x4* xn = (const f32x4*)(src + (size_t)mn * D_) + lane;
        const f32x4* sh = (const f32x4*)(shift + (size_t)b * 6144) + lane; const f32x4* sc = (const f32x4*)(scale + (size_t)b * 6144) + lane;
#pragma unroll
        for (int j = 0; j < 4; ++j) { scv[j] = sc[64 * j]; shv[j] = sh[64 * j]; }
#pragma unroll
        for (int j = 0; j < 4; ++j) vn[j] = __builtin_nontemporal_load(xn + 64 * j);
        float s = 0.f;
#pragma unroll
        for (int j = 0; j < 4; ++j) s += (v[j][0] * v[j][0] + v[j][1] * v[j][1]) + (v[j][2] * v[j][2] + v[j][3] * v[j][3]);
        const float rstd = rsqrtf(wave_sum(s) * (1.0f / D_) + EPS_);
        u32x2* o = (u32x2*)(dst + (size_t)m * D_) + lane;
#pragma unroll
        for (int j = 0; j < 4; ++j) { const f32x4 y = v[j] * rstd * gv[j] * (scv[j] + 1.0f) + shv[j]; u32x2 w; w.x = pk2(y[0], y[1]); w.y = pk2(y[2], y[3]); o[64 * j] = w; }
#pragma unroll
        for (int j = 0; j < 4; ++j) v[j] = vn[j];
    }
}

__device__ __forceinline__ void lru_item(const bf16_t* XR, bf16_t* GR, const float* conv_w, const float* conv_b, const float* w_rg, const float* b_rg,
                                         const float* w_ig, const float* b_ig, const float* lam_p, int item, LAS unsigned char* lds, int tid_in, int dummy) {
    int tid = tid_in; asm volatile("" : "+v"(tid));
    const int wave = __builtin_amdgcn_readfirstlane(tid >> 6), lane = tid & 63;
    const int b = item / 24, cgp = item % 24, blk = cgp >> 1, half = cgp & 1, c0 = blk * 128, oc0 = c0 + half * 64;
    LAS f32x2* TS = (LAS f32x2*)(lds + 69632);
    LAS float* CARRY = (LAS float*)(lds + 69632 + 4096);
    const int mt = wave >> 1, nt = wave & 1, r = lane & 31, hh = lane >> 5;
    bf16x8 Brg[8], Big[8];
    {
        const float* wr_ = w_rg + (size_t)blk * 16384 + half * 64 + 32 * nt + r; const float* wi_ = w_ig + (size_t)blk * 16384 + half * 64 + 32 * nt + r;
#pragma unroll
        for (int s = 0; s < 8; ++s) { float t[8], t2[8];
#pragma unroll
            for (int j = 0; j < 8; ++j) { t[j] = wr_[(16 * s + 8 * hh + j) * 128]; t2[j] = wi_[(16 * s + 8 * hh + j) * 128]; }
            u32x4 p; p.x = pk2(t[0], t[1]); p.y = pk2(t[2], t[3]); p.z = pk2(t[4], t[5]); p.w = pk2(t[6], t[7]); Brg[s] = __builtin_bit_cast(bf16x8, p);
            u32x4 p2; p2.x = pk2(t2[0], t2[1]); p2.y = pk2(t2[2], t2[3]); p2.z = pk2(t2[4], t2[5]); p2.w = pk2(t2[6], t2[7]); Big[s] = __builtin_bit_cast(bf16x8, p2); }
    }
    const float L2E = 1.4426950408889634f;
    const int chl = 32 * nt + r, och = oc0 + chl;
    const float brg = -b_rg[och] * L2E, big = -b_ig[och] * L2E;
    const float nsp = -8.0f * log1pf(expf(-lam_p[och]));
    const float nsp2 = nsp * L2E, nspx = 2.0f * nsp;
    const int cp2 = 2 * lane;
    float cw0[4], cw1[4];
#pragma unroll
    for (int k = 0; k < 4; ++k) { const f32x2 w2 = *(const f32x2*)(conv_w + k * LW + c0 + cp2); cw0[k] = w2[0]; cw1[k] = w2[1]; }
    const f32x2 cb2 = *(const f32x2*)(conv_b + c0 + cp2);
    if (tid < 128) CARRY[tid] = 0.f;
    const bf16_t* xsrc = XR + (size_t)b * SEQ_ * LW + c0 + cp2;
    unsigned xv[19];
    unsigned short gg[16];
#pragma unroll
    for (int j = 0; j < 19; ++j) { const int ts = 16 * wave - 3 + j; const int tsc = ts < 0 ? 0 : ts; const unsigned v = *(const unsigned*)(xsrc + (size_t)tsc * LW); xv[j] = ts < 0 ? 0u : v; }
#define LRU_CONV(XCW) do { _Pragma("unroll") for (int i = 0; i < 16; ++i) { float o0 = cb2[0], o1 = cb2[1]; \
        _Pragma("unroll") for (int k = 0; k < 4; ++k) { o0 += cw0[k] * bf_lo(xv[i + k]); o1 += cw1[k] * bf_hi(xv[i + k]); } \
        *(LAS unsigned*)((XCW) + (16 * wave + i) * 272 + lane * 4) = pk2(o0, o1); } } while (0)
#define LRU_LOADS(c) do { const int c_ = (c); bf16_t* gb_ = GR + ((size_t)b * SEQ_ + c_ * 128 + 32 * mt + 4 * hh) * CATLD + och; \
        _Pragma("unroll") for (int i = 0; i < 16; ++i) gg[i] = gb_[(size_t)((i & 3) + 8 * (i >> 2)) * CATLD]; \
        const int tn_ = (c_ < 31 ? c_ + 1 : c_) * 128 + 16 * wave - 3; \
        _Pragma("unroll") for (int j = 0; j < 19; ++j) xv[j] = *(const unsigned*)(xsrc + (size_t)(tn_ + j) * LW); } while (0)
    LRU_CONV(lds);
    LRU_LOADS(0);
    __syncthreads();
    for (int chn = 0; chn < 32; ++chn) {
        bf16_t* gbase = GR + ((size_t)b * SEQ_ + chn * 128 + 32 * mt + 4 * hh) * CATLD + och;
        LAS unsigned char* XC = lds + (chn & 1) * 34816; LAS unsigned char* XCN = lds + ((chn + 1) & 1) * 34816; LAS f32x2* TSp = TS + (chn & 1) * 256;
        f32x16 aR, aI;
#pragma unroll
        for (int i = 0; i < 16; ++i) { aR[i] = 0.f; aI[i] = 0.f; }
        bf16x8 af[8];
#pragma unroll
        for (int s = 0; s < 8; ++s) af[s] = *(const LAS bf16x8*)(XC + (32 * mt + r) * 272 + (16 * s + 8 * hh) * 2);
        __builtin_amdgcn_sched_barrier(0);
#pragma unroll
        for (int s = 0; s < 8; ++s) { aR = MFMA32(af[s], Brg[s], aR); aI = MFMA32(af[s], Big[s], aI); }
#pragma unroll
        for (int i = 0; i < 16; ++i) { const int tok = 32 * mt + (i & 3) + 8 * (i >> 2) + 4 * hh;
            const float rr = __builtin_amdgcn_rcpf(1.0f + __builtin_amdgcn_exp2f(brg - aR[i] * L2E)), ii = __builtin_amdgcn_rcpf(1.0f + __builtin_amdgcn_exp2f(big - aI[i] * L2E));
            const float av = __builtin_amdgcn_exp2f(nsp2 * rr), x2 = nspx * rr;
            const float ty = -x2 * (1.0f + x2 * 0.5f * (1.0f + x2 * (1.0f / 3.0f) * (1.0f + x2 * 0.25f * (1.0f + x2 * 0.2f * (1.0f + x2 * (1.0f / 6.0f))))));
            const float m2 = x2 > -0.25f ? ty : 1.0f - av * av;
            const float xcv = bf1(*(const LAS unsigned short*)(XC + tok * 272 + (half * 64 + chl) * 2));
            aR[i] = av; aI[i] = __builtin_amdgcn_sqrtf(m2) * (ii * xcv); }
        float Ag[4], hg[4], Agp[4], hgp[4];
#pragma unroll
        for (int g = 0; g < 4; ++g) { float h = aI[4 * g], A = aR[4 * g];
#pragma unroll
            for (int e = 1; e < 4; ++e) { h = aR[4 * g + e] * h + aI[4 * g + e]; A *= aR[4 * g + e]; aI[4 * g + e] = h; aR[4 * g + e] = A; }
            Ag[g] = A; hg[g] = h; Agp[g] = xor32(A); hgp[g] = xor32(h); }
        float PA[4], Ph[4]; float TA = 1.0f, Th = 0.0f;
#pragma unroll
        for (int g = 0; g < 4; ++g) { const float EA = hh ? Agp[g] : Ag[g], Eh = hh ? hgp[g] : hg[g], OA = hh ? Ag[g] : Agp[g], Oh = hh ? hg[g] : hgp[g];
            const float pA0 = TA, ph0 = Th; Th = EA * Th + Eh; TA *= EA;
            PA[g] = hh ? TA : pA0; Ph[g] = hh ? Th : ph0; Th = OA * Th + Oh; TA *= OA; }
        if (hh == 0) TSp[mt * 64 + chl] = (f32x2){TA, Th};
        if (chn < 31) LRU_CONV(XCN);
        __syncthreads();
        float cin = CARRY[(chn & 1) * 64 + chl];
        for (int m2 = 0; m2 < mt; ++m2) { const f32x2 t = TSp[m2 * 64 + chl]; cin = t[0] * cin + t[1]; }
        if (mt == 3 && hh == 0) CARRY[((chn + 1) & 1) * 64 + chl] = TA * cin + Th;
#pragma unroll
        for (int g = 0; g < 4; ++g) { const float cg_ = PA[g] * cin + Ph[g];
#pragma unroll
            for (int e = 0; e < 4; ++e) { const int i = 4 * g + e; const float y = (aI[i] + aR[i] * cg_) * bf1(gg[i]);
                gbase[(size_t)((i & 3) + 8 * (i >> 2)) * CATLD] = dummy ? gg[i] : (unsigned short)(pk2(y, 0.f) & 0xffffu); } }
        if (chn < 31) LRU_LOADS(chn + 1);
    }
#undef LRU_CONV
#undef LRU_LOADS
    __syncthreads();
}

__device__ __forceinline__ void attn_strip(const bf16_t* Q, const bf16_t* Kp, const bf16_t* Vp, bf16_t* O, int sidx, LAS unsigned char* vl, int lane) {
    const int qs = sidx & 127, hd = (sidx >> 7) & 7, b = sidx >> 10;
    const int r = lane & 31, hh = lane >> 5;
    const size_t tok0 = (size_t)b * SEQ_;
    bf16x8 qf[8];
    { const bf16_t* qrow = Q + (tok0 + 32 * qs + r) * CATLD + hd * 128 + 8 * hh;
#pragma unroll
      for (int s = 0; s < 8; ++s) qf[s] = *(const bf16x8*)(qrow + 16 * s); }
    f32x16 oacc[4];
#pragma unroll
    for (int c4 = 0; c4 < 4; ++c4)
#pragma unroll
        for (int i = 0; i < 16; ++i) oacc[c4][i] = 0.f;
    float crun = 0.f;
    const int vrow = lane >> 4, vch = lane & 15;
    const int q4 = (lane & 15) >> 2, p4 = lane & 3, blk = (lane >> 4) & 1;
    LAS unsigned char* trp = vl + (4 * hh + q4) * 320 + (16 * blk + 4 * p4) * 2;
    const bf16_t* kbase = Kp + (tok0 + vrow) * 1024 + hd * 128 + vch * 8;
    const bf16_t* vbase = Vp + (tok0 + vrow) * 1024 + hd * 128 + vch * 8;
    u32x4 kk[8], vv[8];
    LAS unsigned char* kl = vl + 10240;
#define ATT_LOAD(kt_) do { const size_t ko_ = (size_t)(kt_) * 32 * 1024; \
        _Pragma("unroll") for (int i = 0; i < 8; ++i) kk[i] = *(const u32x4*)(kbase + ko_ + (size_t)i * 4096); \
        _Pragma("unroll") for (int i = 0; i < 8; ++i) vv[i] = *(const u32x4*)(vbase + ko_ + (size_t)i * 4096); } while (0)
    ATT_LOAD(qs);
    for (int kt = qs; kt >= 0; --kt) {
#pragma unroll
        for (int i = 0; i < 8; ++i) *(LAS u32x4*)(kl + (vrow + 4 * i) * 272 + vch * 16) = kk[i];
#pragma unroll
        for (int i = 0; i < 8; ++i) *(LAS u32x4*)(vl + (vrow + 4 * i) * 320 + vch * 16) = vv[i];
        LDS_WAIT();
        f32x16 x, x1;
#pragma unroll
        for (int i = 0; i < 16; ++i) { x[i] = 0.f; x1[i] = 0.f; }
#pragma unroll
        for (int s = 0; s < 8; s += 2) { const bf16x8 kf0 = *(const LAS bf16x8*)(kl + r * 272 + (16 * s + 8 * hh) * 2), kf1 = *(const LAS bf16x8*)(kl + r * 272 + (16 * s + 16 + 8 * hh) * 2);
            x = MFMA32(kf0, qf[s], x); x1 = MFMA32(kf1, qf[s + 1], x1); }
#pragma unroll
        for (int i = 0; i < 16; ++i) x[i] += x1[i];
        { const int kn = kt > 0 ? kt - 1 : 0; ATT_LOAD(kn); }
        const bool diag = (kt == qs);
        float lomb[16];
#pragma unroll
        for (int i = 0; i < 16; ++i) { const float z = x[i]; const float e = __builtin_amdgcn_exp2f(-fabsf(z));
            const float sp = fmaxf(z, 0.f) + __builtin_amdgcn_logf(1.0f + e);
            const bool valid = !diag || ((i & 3) + 8 * (i >> 2) + 4 * hh) < r;
            lomb[i] = valid ? -sp : 0.f; }
        float G[4], Gp[4], T[4], hp[4];
#pragma unroll
        for (int g = 0; g < 4; ++g) { G[g] = (lomb[4 * g] + lomb[4 * g + 1]) + (lomb[4 * g + 2] + lomb[4 * g + 3]); Gp[g] = xor32(G[g]); T[g] = G[g] + Gp[g]; hp[g] = hh == 0 ? Gp[g] : 0.f; }
        float after[4];
        after[3] = hp[3]; after[2] = T[3] + hp[2]; after[1] = (T[3] + T[2]) + hp[1]; after[0] = ((T[3] + T[2]) + T[1]) + hp[0];
#pragma unroll
        for (int g = 0; g < 4; ++g) { const float base = crun + after[g];
            const float s3 = 0.f, s2 = lomb[4 * g + 3], s1 = s2 + lomb[4 * g + 2], s0 = s1 + lomb[4 * g + 1];
            const float sf[4] = {s0, s1, s2, s3};
#pragma unroll
            for (int e = 0; e < 4; ++e) { const int i = 4 * g + e; const bool valid = !diag || ((8 * g + 4 * hh + e) < r);
                const float wv = __builtin_amdgcn_exp2f((x[i] + lomb[i]) + (base + sf[e])); x[i] = valid ? wv : 0.f; } }
        crun += ((T[3] + T[2]) + T[1]) + T[0];
        bf16x8 wf[2];
#pragma unroll
        for (int s = 0; s < 2; ++s) { u32x4 p; p.x = pk2(x[8 * s], x[8 * s + 1]); p.y = pk2(x[8 * s + 2], x[8 * s + 3]); p.z = pk2(x[8 * s + 4], x[8 * s + 5]); p.w = pk2(x[8 * s + 6], x[8 * s + 7]); wf[s] = __builtin_bit_cast(bf16x8, p); }
        LDS_WAIT();
        bf16x8 va[2][4];
#pragma unroll
        for (int s = 0; s < 2; ++s)
#pragma unroll
            for (int c4 = 0; c4 < 4; ++c4) {
                const s16x4 lo = __builtin_amdgcn_ds_read_tr16_b64_v4i16((LAS s16x4*)(trp + (16 * s) * 320 + 64 * c4));
                const s16x4 hi = __builtin_amdgcn_ds_read_tr16_b64_v4i16((LAS s16x4*)(trp + (16 * s + 8) * 320 + 64 * c4));
                va[s][c4] = __builtin_shufflevector(lo, hi, 0, 1, 2, 3, 4, 5, 6, 7); }
        __builtin_amdgcn_sched_barrier(0);
#pragma unroll
        for (int s = 0; s < 2; ++s)
#pragma unroll
            for (int c4 = 0; c4 < 4; ++c4) oacc[c4] = MFMA32(va[s][c4], wf[s], oacc[c4]);
        LDS_WAIT();
        if (__ballot(crun < -151.5f) == ~0ull) break;
    }
#undef ATT_LOAD
    bf16_t* orow = O + (tok0 + 32 * qs + r) * CATLD + hd * 128 + 4 * hh;
#pragma unroll
    for (int c4 = 0; c4 < 4; ++c4)
#pragma unroll
        for (int g = 0; g < 4; ++g) { u32x2 w; w.x = pk2(oacc[c4][4 * g], oacc[c4][4 * g + 1]); w.y = pk2(oacc[c4][4 * g + 2], oacc[c4][4 * g + 3]); *(u32x2*)(orow + 32 * c4 + 8 * g) = w; }
}


__device__ __forceinline__ void stagger_start(int bx, int slots) {
    const int n = (bx & 7) * slots;
    for (int i = 0; i < n; ++i) __builtin_amdgcn_s_sleep(20);
    __syncthreads();
}

#define XB_TMO      128
#define XB_XCNT(j)  (256  + 64 * (j))
#define XB_XSUB(j)  (1280 + 64 * (j))
#define XB_XGEN(j)  (2304 + 64 * (j))
#define XB_TOP      3328
#define XB_TOPGEN   3392
#define XCD_BAR_WORDS 3456
#define XB_SPIN_CAP (1u << 18)

__device__ __forceinline__ unsigned xb_ld(unsigned* p)              { return __hip_atomic_load(p, __ATOMIC_RELAXED, __HIP_MEMORY_SCOPE_AGENT); }
__device__ __forceinline__ unsigned xb_add(unsigned* p, unsigned v) { return __hip_atomic_fetch_add(p, v, __ATOMIC_RELAXED, __HIP_MEMORY_SCOPE_AGENT); }
__device__ __forceinline__ unsigned xb_xcc_id() { return (unsigned)__builtin_amdgcn_s_getreg((3 << 11) | 20) & 0xFu; }
#define XB_SPIN(cond, bar) do { unsigned _sp = 0; while (cond) { __builtin_amdgcn_s_sleep(1); \
    if ((++_sp & 255u) == 0u) { if (xb_ld(&(bar)[XB_TMO])) break; if (_sp > XB_SPIN_CAP) { atomicAdd(&(bar)[XB_TMO], 1u); break; } } } } while (0)

struct XcdBarrier {
    unsigned* bar; unsigned x;
    volatile LAS unsigned* st;
};

__device__ __forceinline__ XcdBarrier xcd_barrier_post(unsigned* bar, volatile LAS unsigned* st) {
    XcdBarrier b; b.bar = bar; b.x = xb_xcc_id(); b.st = st;
    if (threadIdx.x == 0) (void)xb_add(&bar[XB_XCNT(b.x)], 1u);
    return b;
}
__device__ __forceinline__ void xcd_barrier_complete(unsigned* bar, unsigned x, unsigned& nloc, unsigned& nx) {
    const unsigned G = gridDim.x * gridDim.y * gridDim.z;
    unsigned sum, cnt, mine, sp = 0u;
    for (;;) {
        sum = 0u; cnt = 0u; mine = 0u;
#pragma unroll
        for (unsigned j = 0; j < 16; ++j) { const unsigned c = xb_ld(&bar[XB_XCNT(j)]); sum += c; cnt += (c > 0u) ? 1u : 0u; mine = (j == x) ? c : mine; }
        if (sum == G) break;
        __builtin_amdgcn_s_sleep(1);
        if ((++sp & 255u) == 0u) { if (xb_ld(&bar[XB_TMO])) break; if (sp > XB_SPIN_CAP) { atomicAdd(&bar[XB_TMO], 1u); break; } }
    }
    nloc = mine > 0u ? mine : 1u; nx = cnt > 0u ? cnt : 1u;
}

__device__ __forceinline__ void xcd_barrier(const XcdBarrier& b) {
    asm volatile("s_waitcnt vmcnt(0)" ::: "memory");
    __syncthreads();
    if (threadIdx.x == 0) {
        unsigned* bar = b.bar;
        __builtin_amdgcn_s_waitcnt(0);
        unsigned nloc = b.st[0], nx = b.st[1];
        if (nloc == 0u) { xcd_barrier_complete(bar, b.x, nloc, nx); b.st[0] = nloc; b.st[1] = nx; }
        const unsigned old = xb_add(&bar[XB_XSUB(b.x)], 1u);
        const unsigned gen = old / nloc;
        if (old + 1u == (gen + 1u) * nloc) {
            __builtin_amdgcn_fence(__ATOMIC_RELEASE, "agent");
            asm volatile("s_waitcnt vmcnt(0)" ::: "memory");
            const unsigned og = xb_add(&bar[XB_TOP], 1u);
            const unsigned tg = og / nx;
            if (og + 1u == (tg + 1u) * nx) xb_add(&bar[XB_TOPGEN], 1u);
            else XB_SPIN(xb_ld(&bar[XB_TOPGEN]) == tg, bar);
            __builtin_amdgcn_fence(__ATOMIC_ACQUIRE, "agent");
            xb_add(&bar[XB_XGEN(b.x)], 1u);
            asm volatile("s_waitcnt vmcnt(0)" ::: "memory");
        } else {
            XB_SPIN(xb_ld(&bar[XB_XGEN(b.x)]) == gen, bar);
            __builtin_amdgcn_fence(__ATOMIC_ACQUIRE, "agent");
            asm volatile("s_waitcnt vmcnt(0)" ::: "memory");
        }
    }
    __syncthreads();
}

struct Args { const float* in[21]; float* out; unsigned char* ws; int ph_lo, ph_hi; };
__global__ void __launch_bounds__(512, 2) fwd_kernel(Args a) {
    extern __shared__ __attribute__((aligned(16))) unsigned char lds_[];
    LAS unsigned char* lds = (LAS unsigned char*)lds_;
    cg::grid_group grid = cg::this_grid();
    const int tid = threadIdx.x, lane = tid & 63, wave = __builtin_amdgcn_readfirstlane(tid >> 6);
    const int G = gridDim.x, bx = blockIdx.x, gw = bx * 8 + wave, ngw = G * 8;
    unsigned char* ws = a.ws;
    bf16_t* Qb = (bf16_t*)(ws + WS_CAT); bf16_t* Kb = (bf16_t*)(ws + WS_K); bf16_t* Vb = (bf16_t*)(ws + WS_V); bf16_t* XRb = (bf16_t*)(ws + WS_XR); bf16_t* GRb = Qb + 1024;
    bf16_t* Hb = (bf16_t*)(ws + WS_H); bf16_t* MRGb = (bf16_t*)(ws + WS_MERGED); bf16_t* ACTb = (bf16_t*)(ws + WS_ACT);
    bf16_t* Win = (bf16_t*)(ws + WS_WIN); bf16_t* Wcat = (bf16_t*)(ws + WS_WCAT); bf16_t* Wout = (bf16_t*)(ws + WS_WOUT);
    bf16_t* Wf1 = (bf16_t*)(ws + WS_WF1); bf16_t* Wf2 = (bf16_t*)(ws + WS_WF2);
    float* mod = (float*)(ws + WS_MOD); unsigned* ctl = (unsigned*)(ws + WS_CTL);
    bf16_t* SGA = (bf16_t*)a.out; bf16_t* SGB = (bf16_t*)a.out + (size_t)MTOK * 1024;
    const float* x = a.in[0];

#define IN(k) (a.ph_lo <= (k) && (k) < a.ph_hi)
#define SEAM(k) do { if (IN(k) && IN((k) + 1)) { if (a.ph_hi > NPHASE) grid.sync(); else xcd_barrier(xbar); } } while (0)
    XcdBarrier xbar; xbar.bar = ctl + 1024; xbar.x = 0; xbar.st = (volatile LAS unsigned*)(lds + 8 * 18944 + 32);
    if (a.ph_hi - a.ph_lo > 1) { if (tid == 0) { xbar.st[0] = 0u; xbar.st[1] = 0u; } __syncthreads(); xbar = xcd_barrier_post(ctl + 1024, (volatile LAS unsigned*)(lds + 8 * 18944 + 32)); }
    {
        if (IN(0)) {
            for (int it = bx; it < 192; it += G) adaln_item(a.in[1], a.in[2], a.in[3], mod, it, lds, tid);
            LAS float* scr = (LAS float*)(lds + wave * 8448);
            constexpr int I_IN = 16 * 256, I_PA = 16 * 32, I_PL = 24 * 32, I_OUT = 16 * 32, I_F1 = 16 * 176, I_F2 = 44 * 32;
            constexpr int NIT = I_IN + I_PA + I_PL + I_OUT + I_F1 + I_F2;
            for (int it = gw; it < NIT; it += ngw) {
                int rr = it;
                if (rr < I_IN) { transpose_item<false>(a.in[5], 1024, NIN, Win, 1024, 0, scr, rr, lane); continue; } rr -= I_IN;
                if (rr < I_PA) { transpose_item<false>(a.in[15], 1024, 1024, Wcat, CATLD, 0, scr, rr, lane); continue; } rr -= I_PA;
                if (rr < I_PL) { transpose_item<false>(a.in[16], LW, 1024, Wcat, CATLD, 1024, scr, rr, lane); continue; } rr -= I_PL;
                if (rr < I_OUT) { transpose_item<false>(a.in[17], 1024, 1024, Wout, 1024, 0, scr, rr, lane); continue; } rr -= I_OUT;
                if (rr < I_F1) { transpose_item<true>(a.in[19], 1024, 2 * FFH, Wf1, 1024, 0, scr, rr, lane); continue; } rr -= I_F1;
                transpose_item<false>(a.in[20], FFH, 1024, Wf2, FFH, 0, scr, rr, lane);
            }
        }
        SEAM(0);
        if (IN(1)) {
            norm_rows(x, a.in[4], mod, mod + 1024, Hb, gw, ngw, lane);
        }
        SEAM(1);
        if (IN(2)) {
            stagger_start(bx, STAG_G1);
            pg8::Gemm g{Hb, Win, MTOK, NIN, 1024}; pg8::StaticOrder S; S.init(MTOK, NIN, G, bx);
            EpiIn E{Qb, Kb, Vb, XRb, SGA, SGB, a.in[6], a.in[7], (LAS float*)(lds + 131072)};
            pg8::gemm_phase<EpiIn, pg8::StaticOrder, GEMM_ALIGN, GEMM_SP2>(lds, g, S, E);
        }
        SEAM(2);
        if (IN(3)) {
            const int dummy = 0;
            for (int it = bx; it < 192; it += G) lru_item(XRb, GRb, a.in[8], a.in[9], a.in[10], a.in[11], a.in[12], a.in[13], a.in[14], it, lds, tid, dummy);
            int lane_o = lane; asm volatile("" : "+v"(lane_o));
            LAS unsigned char* vl = lds + wave * 18944;
            unsigned* cnt = ctl + 16 * dummy; bf16_t* Odst = dummy ? Hb : Qb;
            LAS unsigned* qword = (LAS unsigned*)(lds + 8 * 18944);
            for (;;) {
                __syncthreads();
                if (tid == 0) *qword = __hip_atomic_fetch_add(cnt, 8u, __ATOMIC_RELAXED, __HIP_MEMORY_SCOPE_AGENT);
                __syncthreads();
                const unsigned s = *qword + (unsigned)wave;
                if (s >= (unsigned)(NB * NH * 128)) break;
                attn_strip(Qb, Kb, Vb, Odst, (int)s, vl, lane_o);
            }
        }
        SEAM(3);
        if (IN(4)) {
            pg8::Gemm g{Qb, Wcat, MTOK, 1024, CATLD}; pg8::StaticOrder S; S.init(MTOK, 1024, G, bx);
            EpiMerge E{SGA, SGB, MRGb}; pg8::gemm_phase<EpiMerge, pg8::StaticOrder, GEMM_ALIGN, GEMM_SP2>(lds, g, S, E);
        }
        SEAM(4);
        if (IN(5)) {
            pg8::Gemm g{MRGb, Wout, MTOK, 1024, 1024}; pg8::StaticOrder S; S.init(MTOK, 1024, G, bx);
            EpiResid E{x, a.out, mod + 2 * 1024}; pg8::gemm_phase<EpiResid, pg8::StaticOrder, GEMM_ALIGN, GEMM_SP2>(lds, g, S, E);
        }
        SEAM(5);
        if (IN(6)) {
            norm_rows(a.out, a.in[18], mod + 3 * 1024, mod + 4 * 1024, Hb, gw, ngw, lane);
        }
        SEAM(6);
        if (IN(7)) {
            stagger_start(bx, STAG_G5);
            pg8::Gemm g{Hb, Wf1, MTOK, 2 * FFH, 1024}; pg8::StaticOrder S; S.init(MTOK, 2 * FFH, G, bx);
            EpiSwiglu E{ACTb}; pg8::gemm_phase<EpiSwiglu, pg8::StaticOrder, GEMM_ALIGN, GEMM_SP2>(lds, g, S, E);
        }
        SEAM(7);
        if (IN(8)) {
            pg8::Gemm g{ACTb, Wf2, MTOK, 1024, FFH}; pg8::StaticOrder S; S.init(MTOK, 1024, G, bx);
            EpiResid E{a.out, a.out, mod + 5 * 1024}; pg8::gemm_phase<EpiResid, pg8::StaticOrder, GEMM_ALIGN, GEMM_SP2>(lds, g, S, E);
        }
    }
#undef IN
#undef SEAM
}

extern "C" void kernel_launch(void* const* d_in, const int* in_sizes, int n_in, void* d_out, int out_size, void* d_ws, size_t ws_size, hipStream_t stream) {
    static int grid = 0;
    if (grid == 0) {
        if (n_in != 21 || in_sizes[0] != MTOK * D_ || out_size != MTOK * D_ || ws_size < WS_END) { fprintf(stderr, "kernel_launch: unexpected shapes / workspace (%d inputs, ws %zu < %zu)\n", n_in, ws_size, (size_t)WS_END); grid = -1; return; }
        int dev = 0, cus = 0, per_cu = 0;
        hipGetDevice(&dev); hipDeviceGetAttribute(&cus, hipDeviceAttributeMultiprocessorCount, dev);
        if (hipFuncSetAttribute((const void*)fwd_kernel, hipFuncAttributeMaxDynamicSharedMemorySize, LDS_BYTES) != hipSuccess) { fprintf(stderr, "kernel_launch: hipFuncSetAttribute failed\n"); grid = -1; return; }
        if (hipOccupancyMaxActiveBlocksPerMultiprocessor(&per_cu, (const void*)fwd_kernel, 512, LDS_BYTES) != hipSuccess || per_cu < 1) { fprintf(stderr, "kernel_launch: occupancy query says %d\n", per_cu); per_cu = 1; }
        (void)hipGetLastError();
        grid = cus > 0 ? cus : 256;
    }
    if (grid < 0) return;
    (void)hipMemsetAsync((char*)d_ws + WS_CTL, 0, 20480, stream);
    Args a{};
    for (int i = 0; i < 21; ++i) a.in[i] = (const float*)d_in[i];
    a.out = (float*)d_out; a.ws = (unsigned char*)d_ws;
#if MK_PER_PHASE
    for (int ph = 0; ph < NPHASE; ++ph) { a.ph_lo = ph; a.ph_hi = ph + 1; hipLaunchKernelGGL(fwd_kernel, dim3(grid), dim3(512), LDS_BYTES, stream, a); }
#else
    a.ph_lo = 0; a.ph_hi = NPHASE;
    void* args[] = {&a};
    hipError_t e = hipLaunchCooperativeKernel((void*)fwd_kernel, dim3(grid), dim3(512), args, LDS_BYTES, stream);
    if (e != hipSuccess) fprintf(stderr, "cooperative launch failed: %s (grid %d)\n", hipGetErrorString(e), grid);
#endif
}
```

```cpp
#include <hip/hip_runtime.h>
#include <hip/hip_cooperative_groups.h>
#include <cstdio>
namespace cg = cooperative_groups;

#ifndef MK_PER_PHASE
#define MK_PER_PHASE 0
#endif

#define LAS __attribute__((address_space(3)))
typedef float f32x2 __attribute__((ext_vector_type(2)));
typedef float f32x16 __attribute__((ext_vector_type(16)));
typedef __bf16 bf16x2_t __attribute__((ext_vector_type(2)));
typedef short s16x4 __attribute__((ext_vector_type(4)));
typedef unsigned u32x2 __attribute__((ext_vector_type(2)));

constexpr int D_ = 1024, NB = 8, SEQ_ = 4096, MTOK = NB * SEQ_, NH = 8, DH = 128, LW = 1536, FFH = 2816, NIN = 8192;
constexpr float EPS_ = 1e-6f;
constexpr size_t MIB = 1048576;
constexpr int CATLD = 2560;
constexpr size_t WS_CAT = 0, WS_K = 160 * MIB, WS_V = 224 * MIB, WS_XR = 288 * MIB, WS_H = 384 * MIB;
constexpr size_t WS_WIN = 448 * MIB, WS_WCAT = 464 * MIB, WS_WOUT = 469 * MIB, WS_WF1 = 471 * MIB, WS_WF2 = 482 * MIB;
constexpr size_t WS_MOD = 488 * MIB, WS_CTL = 489 * MIB, WS_END = 489 * MIB + 32768;
constexpr size_t WS_MERGED = WS_K, WS_ACT = 0;
constexpr int LDS_BYTES = 8 * 18944 + 64;
constexpr int NPHASE = 9;
constexpr bool GEMM_ALIGN = true, GEMM_SP2 = true;
constexpr int STAG_G1 = 0, STAG_G5 = 0;

__device__ __forceinline__ unsigned pk2(float a, float b) { f32x2 v = {a, b}; bf16x2_t r = __builtin_convertvector(v, bf16x2_t); return __builtin_bit_cast(unsigned, r); }
__device__ __forceinline__ float bf_lo(unsigned w) { return __uint_as_float(w << 16); }
__device__ __forceinline__ float bf_hi(unsigned w) { return __uint_as_float(w & 0xffff0000u); }
__device__ __forceinline__ float bf1(unsigned short w) { return __uint_as_float(((unsigned)w) << 16); }
__device__ __forceinline__ float fast_sigmoid(float x) { return __builtin_amdgcn_rcpf(1.0f + __expf(-x)); }
__device__ __forceinline__ float gelu_tanh(float x) { const float t = 1.5957691216057308f * (x + 0.044715f * x * x * x); return x * fast_sigmoid(t); }
#define LDS_WAIT() asm volatile("s_waitcnt lgkmcnt(0)" ::: "memory")
#define ST_EPI(last_, val_, ptr_) do { if (last_) __builtin_nontemporal_store((val_), (ptr_)); else *(ptr_) = (val_); } while (0)
__device__ __forceinline__ float xor32(float v) {
    const unsigned u = __float_as_uint(v);
    auto r = __builtin_amdgcn_permlane32_swap(u, u, false, false);
    return __uint_as_float((threadIdx.x & 32) ? (unsigned)r[0] : (unsigned)r[1]);
}

namespace pg8 {
#define PG8_LAS __attribute__((address_space(3)))
typedef unsigned short bf16_t;
typedef short bf16x8 __attribute__((ext_vector_type(8)));
typedef float f32x4 __attribute__((ext_vector_type(4)));
typedef unsigned u32x4 __attribute__((ext_vector_type(4)));
constexpr int BM = 256, BK = 64, HALF = 128, HTB = HALF * BK * 2  , STAGE_BYTES = 8 * HTB, NXCD = 8, WGM = 8;

__host__ __device__ __forceinline__ int lds_byte(int r, int c) { const int st = (r >> 4) * 2 + (c >> 5), rr = r & 15, cc = c & 31, ob = rr * 64 + cc * 2; return st * 1024 + (ob ^ (((ob >> 9) & 1) << 5)); }
__host__ __device__ __forceinline__ void stage_rc(int b, int& R, int& C) { const int st = b / 1024, sb = b % 1024, swz = sb ^ (((sb >> 9) & 1) << 5); R = (st >> 1) * 16 + swz / 64; C = (st & 1) * 32 + (swz % 64) / 2; }
__host__ __device__ __forceinline__ int perm32(int rho) { const int n = rho >> 4, i = rho & 15; return 8 * (i >> 2) + 4 * n + (i & 3); }

struct Unit { int pm, pn, last; };
struct Gemm { const bf16_t* A; const bf16_t* Bt; int M, N, K; };

struct StaticOrder {
    int nM, nN, nwg, G, c;
    __host__ __device__ void init(int M, int N, int G_, int c_) { nM = M / BM; nN = N / BM; nwg = nM * nN; G = G_; c = c_; }
    __host__ __device__ bool next(int i, Unit& u) const {
        const long L = (long)i * G + c; if (L >= nwg) return false;
        int wgid = (int)L; { const int q = nwg / NXCD, r = nwg % NXCD, xcd = wgid % NXCD, off = wgid / NXCD; wgid = (xcd < r ? xcd * (q + 1) : r * (q + 1) + (xcd - r) * q) + off; }
        const int nig = WGM * nN, gid = wgid / nig, fm = gid * WGM, gsz = (nM - fm) < WGM ? (nM - fm) : WGM;
        u.pm = fm + ((wgid % nig) % gsz); u.pn = (wgid % nig) / gsz; return true;
    }
    __device__ __forceinline__ void a_ready(const Unit&) const {}
    __device__ __forceinline__ void done(const Unit&) const {}
};
template <class Epi, class Sched, bool ALIGN_EPI = false, bool SP2 = false>
__device__ __forceinline__ void gemm_phase(PG8_LAS unsigned char* lds, const Gemm g, const Sched& S, const Epi& E) {
    int tid_ = threadIdx.x; asm volatile("" : "+v"(tid_));
    const int tid = tid_, wid = __builtin_amdgcn_readfirstlane(tid >> 6), lane = tid & 63, wr = wid >> 2, wc = wid & 3, fr = lane & 15, fq = lane >> 4;
    const int K = g.K, nt = K / BK;
    unsigned voffA[2], voffB[2];
#pragma unroll
    for (int i = 0; i < 2; ++i) { int R, C; stage_rc(tid * 16 + i * 8192, R, C); const int Rb = Epi::PERM ? ((R & ~31) + perm32(R & 31)) : R;
        voffA[i] = (unsigned)(R * K + C) * 2u; voffB[i] = (unsigned)(Rb * K + C) * 2u; }
    const size_t kstep = (size_t)(BK * 2);
    const size_t hstep = (size_t)HALF * K * 2;
    const size_t tstep = 2 * hstep;
    const unsigned ldsw = (unsigned)wid * 1024u;
    const int aoff = lds_byte(wr * 64 + fr, fq * 8), boff = lds_byte(wc * 32 + fr, fq * 8);
#define PG8_SA(b, h) (((b) * 2 + (h)) * HTB)
#define PG8_SB(b, h) ((4 + (b) * 2 + (h)) * HTB)
#define PG8_STAGE(bufoff, gbase, voff) do { _Pragma("unroll") for (int _i = 0; _i < 2; ++_i) \
        __builtin_amdgcn_global_load_lds((const unsigned*)((const char*)(gbase) + (voff)[_i]), (PG8_LAS unsigned*)(lds + (bufoff) + ldsw + _i * 8192), 16, 0, 0); } while (0)
#define PG8_LDA(dst, b, h) do { _Pragma("unroll") for (int m = 0; m < 4; ++m) _Pragma("unroll") for (int k = 0; k < 2; ++k) dst[m][k] = *(const PG8_LAS bf16x8*)(lds + PG8_SA(b, h) + aoff + m * 2048 + k * 1024); } while (0)
#define PG8_LDB(dst, b, h) do { _Pragma("unroll") for (int n = 0; n < 2; ++n) _Pragma("unroll") for (int k = 0; k < 2; ++k) dst[n][k] = *(const PG8_LAS bf16x8*)(lds + PG8_SB(b, h) + boff + n * 2048 + k * 1024); } while (0)
#define PG8_MMA(ai, bj, At, Bt) do { __builtin_amdgcn_s_setprio(1); _Pragma("unroll") for (int m = 0; m < 4; ++m) _Pragma("unroll") for (int n = 0; n < 2; ++n) _Pragma("unroll") for (int k = 0; k < 2; ++k) \
        acc[ai][bj][m][n] = __builtin_amdgcn_mfma_f32_16x16x32_bf16(Bt[n][k], At[m][k], acc[ai][bj][m][n], 0, 0, 0); __builtin_amdgcn_s_setprio(0); } while (0)
#define PG8_WAIT_V(n) asm volatile("s_waitcnt vmcnt(" #n ")" ::: "memory")
#define PG8_WAIT_L(n) asm volatile("s_waitcnt lgkmcnt(" #n ")" ::: "memory")
#define PG8_BAR __builtin_amdgcn_s_barrier()
#define PG8_SCHED __builtin_amdgcn_sched_barrier(0)
    Unit cur, nxt; int ui = 0;
    if (!S.next(0, cur)) return;
    f32x4 acc[2][2][4][2];
#pragma unroll
    for (int a = 0; a < 2; ++a)
#pragma unroll
        for (int b = 0; b < 2; ++b)
#pragma unroll
            for (int m = 0; m < 4; ++m)
#pragma unroll
                for (int n = 0; n < 2; ++n) acc[a][b][m][n] = (f32x4){0.f, 0.f, 0.f, 0.f};
    bf16x8 At[4][2], B0[2][2], B1[2][2];
    const char* cA = (const char*)g.A + (size_t)cur.pm * tstep; const char* cB = (const char*)g.Bt + (size_t)cur.pn * tstep;
    S.a_ready(cur);
    if constexpr (SP2) {
        PG8_STAGE(PG8_SB(0, 0), cB, voffB); PG8_STAGE(PG8_SB(0, 1), cB + hstep, voffB); PG8_STAGE(PG8_SA(0, 0), cA, voffA); PG8_STAGE(PG8_SA(0, 1), cA + hstep, voffA);
        if (wr == 1) PG8_BAR;
        PG8_WAIT_V(2); PG8_BAR;
        PG8_STAGE(PG8_SB(1, 0), cB + kstep, voffB); PG8_STAGE(PG8_SA(1, 0), cA + kstep, voffA); PG8_STAGE(PG8_SB(1, 1), cB + hstep + kstep, voffB);
        PG8_WAIT_V(6); PG8_BAR;
    } else {
        PG8_STAGE(PG8_SB(0, 0), cB, voffB); PG8_STAGE(PG8_SA(0, 0), cA, voffA); PG8_STAGE(PG8_SB(0, 1), cB + hstep, voffB); PG8_STAGE(PG8_SA(0, 1), cA + hstep, voffA);
        if (wr == 1) PG8_BAR;
        PG8_WAIT_V(4); PG8_BAR;
        PG8_STAGE(PG8_SB(1, 0), cB + kstep, voffB); PG8_STAGE(PG8_SA(1, 0), cA + kstep, voffA); PG8_STAGE(PG8_SB(1, 1), cB + hstep + kstep, voffB);
        PG8_WAIT_V(6); PG8_BAR;
    }
    for (;;) {
        const bool has_next = S.next(ui + 1, nxt);
        const char* nA = has_next ? (const char*)g.A + (size_t)nxt.pm * tstep : cA; const char* nB = has_next ? (const char*)g.Bt + (size_t)nxt.pn * tstep : cB;
        for (int t = 0; t < nt; t += 2) {
            const bool last = (t == nt - 2);
            const char* a1 = cA + (size_t)(t + 1) * kstep;
            const char* a2 = last ? nA : cA + (size_t)(t + 2) * kstep; const char* b2 = last ? nB : cB + (size_t)(t + 2) * kstep;
            const char* a3 = a2 + kstep; const char* b3 = b2 + kstep;
            if (last && has_next) S.a_ready(nxt);
            if constexpr (Epi::MID_T >= 0) { if (t == Epi::MID_T) E.mid(acc, cur, wr, wc, fr, fq); }
            if constexpr (SP2) {
            PG8_LDB(B0, 0, 0); PG8_LDB(B1, 0, 1); PG8_SCHED; PG8_LDA(At, 0, 0); PG8_STAGE(PG8_SA(1, 1), a1 + hstep, voffA);
            PG8_WAIT_V(8); PG8_WAIT_L(0); PG8_BAR; PG8_MMA(0, 0, At, B0); PG8_MMA(0, 1, At, B1); PG8_BAR; PG8_SCHED;
            PG8_LDA(At, 0, 1); PG8_STAGE(PG8_SB(0, 0), b2, voffB); PG8_STAGE(PG8_SB(0, 1), b2 + hstep, voffB); PG8_STAGE(PG8_SA(0, 0), a2, voffA);
            PG8_WAIT_V(8); PG8_WAIT_L(0); PG8_BAR; PG8_MMA(1, 0, At, B0); PG8_MMA(1, 1, At, B1); PG8_BAR; PG8_SCHED;
            PG8_LDB(B0, 1, 0); PG8_LDB(B1, 1, 1); PG8_SCHED; PG8_LDA(At, 1, 0); PG8_STAGE(PG8_SA(0, 1), a2 + hstep, voffA);
            PG8_WAIT_V(8); PG8_WAIT_L(0); PG8_BAR; PG8_MMA(0, 0, At, B0); PG8_MMA(0, 1, At, B1); PG8_BAR; PG8_SCHED;
            PG8_LDA(At, 1, 1); PG8_STAGE(PG8_SB(1, 0), b3, voffB); PG8_STAGE(PG8_SB(1, 1), b3 + hstep, voffB); PG8_STAGE(PG8_SA(1, 0), a3, voffA);
            PG8_WAIT_V(8); PG8_WAIT_L(0); PG8_BAR; PG8_MMA(1, 0, At, B0); PG8_MMA(1, 1, At, B1); PG8_BAR; PG8_SCHED;
            } else {
            PG8_LDB(B0, 0, 0); PG8_SCHED; PG8_LDA(At, 0, 0); PG8_STAGE(PG8_SA(1, 1), a1 + hstep, voffA);
            PG8_WAIT_L(8); PG8_BAR; PG8_WAIT_L(0); PG8_MMA(0, 0, At, B0); PG8_BAR; PG8_SCHED;
            PG8_LDB(B1, 0, 1); PG8_STAGE(PG8_SB(0, 0), b2, voffB);
            PG8_BAR; PG8_WAIT_L(0); PG8_MMA(0, 1, At, B1); PG8_BAR;
            PG8_LDA(At, 0, 1); PG8_STAGE(PG8_SA(0, 0), a2, voffA);
            PG8_BAR; PG8_WAIT_L(0); PG8_MMA(1, 0, At, B0); PG8_BAR; PG8_SCHED;
            PG8_STAGE(PG8_SB(0, 1), b2 + hstep, voffB);
            PG8_WAIT_V(6); PG8_BAR; PG8_MMA(1, 1, At, B1); PG8_BAR;
            PG8_LDB(B0, 1, 0); PG8_SCHED; PG8_LDA(At, 1, 0); PG8_STAGE(PG8_SA(0, 1), a2 + hstep, voffA);
            PG8_WAIT_L(8); PG8_BAR; PG8_WAIT_L(0); PG8_MMA(0, 0, At, B0); PG8_BAR; PG8_SCHED;
            PG8_LDB(B1, 1, 1); PG8_STAGE(PG8_SB(1, 0), b3, voffB);
            PG8_BAR; PG8_WAIT_L(0); PG8_MMA(0, 1, At, B1); PG8_BAR;
            PG8_LDA(At, 1, 1); PG8_STAGE(PG8_SA(1, 0), a3, voffA);
            PG8_BAR; PG8_WAIT_L(0); PG8_MMA(1, 0, At, B0); PG8_BAR; PG8_SCHED;
            PG8_STAGE(PG8_SB(1, 1), b3 + hstep, voffB);
            PG8_WAIT_V(6); PG8_BAR; PG8_MMA(1, 1, At, B1); PG8_BAR;
            }
        }
        if constexpr (ALIGN_EPI) { if (wr == 0) PG8_BAR; }
        cur.last = has_next ? 0 : 1;
        if constexpr (!Epi::AFTER_DRAIN) { E(acc, cur, wr, wc, fr, fq); S.done(cur); }
        if (!has_next) break;
#pragma unroll
        for (int a = 0; a < 2; ++a)
#pragma unroll
            for (int b = 0; b < 2; ++b)
#pragma unroll
                for (int m = 0; m < 4; ++m)
#pragma unroll
                    for (int n = 0; n < 2; ++n) acc[a][b][m][n] = (f32x4){0.f, 0.f, 0.f, 0.f};
        cur = nxt; cA = nA; cB = nB; ++ui;
        if constexpr (ALIGN_EPI) { if (wr == 1) PG8_BAR; }
    }
    PG8_WAIT_V(0);
    if constexpr (!ALIGN_EPI) { if (wr == 0) PG8_BAR; }
    PG8_BAR;
    if constexpr (Epi::AFTER_DRAIN) { E.fused(acc, cur, wr, wc, fr, fq, lds, wid, lane); S.done(cur); }
#undef PG8_SA
#undef PG8_SB
#undef PG8_STAGE
#undef PG8_LDA
#undef PG8_LDB
#undef PG8_MMA
#undef PG8_WAIT_V
#undef PG8_WAIT_L
#undef PG8_BAR
#undef PG8_SCHED
}
}

using pg8::bf16_t; using pg8::bf16x8; using pg8::f32x4; using pg8::u32x4; using pg8::Unit;
#define MFMA32(a, b, c) __builtin_amdgcn_mfma_f32_32x32x16_bf16((a), (b), (c), 0, 0, 0)

template <int ACT> __device__ __forceinline__ float act_f(float x) { return ACT == 1 ? gelu_tanh(x) : (ACT == 2 ? fast_sigmoid(x) : x); }
template <int ACT> __device__ __forceinline__ void store_tile_bf16(const f32x4 (&acc)[2][2][4][2], bf16_t* dst, int ld, int row0, int col0, int last) {
#pragma unroll
    for (int ai = 0; ai < 2; ++ai)
#pragma unroll
        for (int m = 0; m < 4; ++m) { bf16_t* rowp = dst + (size_t)(row0 + ai * 128 + m * 16) * ld + col0;
#pragma unroll
            for (int bj = 0; bj < 2; ++bj) { const f32x4 v0 = acc[ai][bj][m][0], v1 = acc[ai][bj][m][1]; u32x4 w;
                w.x = pk2(act_f<ACT>(v0[0]), act_f<ACT>(v0[1])); w.y = pk2(act_f<ACT>(v0[2]), act_f<ACT>(v0[3]));
                w.z = pk2(act_f<ACT>(v1[0]), act_f<ACT>(v1[1])); w.w = pk2(act_f<ACT>(v1[2]), act_f<ACT>(v1[3]));
                ST_EPI(last, w, (u32x4*)(rowp + bj * 128)); } asm volatile("" ::: "memory"); }
}
struct EpiIn {
    static constexpr bool PERM = true, AFTER_DRAIN = false; static constexpr int MID_T = -1;
    bf16_t *cat, *k, *v, *xr, *sga, *sgb; const float *qg, *kg; LAS float* P;
    __device__ __forceinline__ void operator()(const f32x4 (&acc)[2][2][4][2], const Unit& u, int wr, int wc, int fr, int fq) const {
        const int pn = u.pn, row0 = u.pm * 256 + wr * 64 + fr, colw = wc * 32 + 8 * fq;
        if (pn < 8) {
            const bool isq = pn < 4; bf16_t* dst = isq ? cat : k; const float* gw = isq ? qg : kg; const int colt = (pn & 3) * 256, ldq = isq ? CATLD : 1024;
            const int pbase = wr * 1024 + fr * 4;
#pragma unroll
            for (int ai = 0; ai < 2; ++ai)
#pragma unroll
                for (int bj = 0; bj < 2; ++bj)
#pragma unroll
                    for (int m = 0; m < 4; ++m) { const f32x4 a0 = acc[ai][bj][m][0], a1 = acc[ai][bj][m][1];
                        float s = (a0[0] * a0[0] + a0[1] * a0[1]) + (a0[2] * a0[2] + a0[3] * a0[3]) + (a1[0] * a1[0] + a1[1] * a1[1]) + (a1[2] * a1[2] + a1[3] * a1[3]);
                        s += __shfl_xor(s, 16); s += __shfl_xor(s, 32);
                        if (fq == 0) P[pbase + ((ai * 2 + bj) * 4 + m) * 64 + wc] = s; }
            LDS_WAIT(); __builtin_amdgcn_s_barrier(); asm volatile("" ::: "memory");
            const f32x4 g0 = *(const f32x4*)(gw + colw), g1 = *(const f32x4*)(gw + colw + 4);
            const float sc = isq ? 0.12751743f : 1.0f;
#pragma unroll
            for (int ai = 0; ai < 2; ++ai)
#pragma unroll
                for (int m = 0; m < 4; ++m) { bf16_t* rowp = dst + (size_t)(row0 + ai * 128 + m * 16) * ldq + colt + colw;
#pragma unroll
                    for (int bj = 0; bj < 2; ++bj) { const f32x4 p = *(const LAS f32x4*)(P + pbase + ((ai * 2 + bj) * 4 + m) * 64);
                        const float rs = rsqrtf(((p[0] + p[1]) + (p[2] + p[3])) * (1.0f / 128.0f) + EPS_) * sc;
                        const f32x4 v0 = acc[ai][bj][m][0] * rs * g0, v1 = acc[ai][bj][m][1] * rs * g1; u32x4 w;
                        w.x = pk2(v0[0], v0[1]); w.y = pk2(v0[2], v0[3]); w.z = pk2(v1[0], v1[1]); w.w = pk2(v1[2], v1[3]);
                        ST_EPI(u.last, w, (u32x4*)(rowp + bj * 128)); } asm volatile("" ::: "memory"); }
        }
        else if (pn < 12) store_tile_bf16<0>(acc, v, 1024, row0, (pn - 8) * 256 + colw, u.last);
        else if (pn < 18) store_tile_bf16<0>(acc, xr, LW, row0, (pn - 12) * 256 + colw, u.last);
        else if (pn < 24) store_tile_bf16<1>(acc, cat, CATLD, row0, 1024 + (pn - 18) * 256 + colw, u.last);
        else if (pn < 28) store_tile_bf16<2>(acc, sga, 1024, row0, (pn - 24) * 256 + colw, u.last);
        else store_tile_bf16<2>(acc, sgb, 1024, row0, (pn - 28) * 256 + colw, u.last);
    }
};
struct EpiMerge {
    static constexpr bool PERM = true, AFTER_DRAIN = false; static constexpr int MID_T = 16;
    const bf16_t* sga; const bf16_t* sgb; bf16_t* dst;
    static __device__ __forceinline__ float rc(float x) { return __builtin_amdgcn_rcpf(fmaxf(x, 1e-18f)); }
    static __device__ __forceinline__ float cl(float x) { return fmaxf(x, 1e-18f); }
    __device__ __forceinline__ void mid(f32x4 (&acc)[2][2][4][2], const Unit& u, int wr, int wc, int fr, int fq) const {
        int fr_ = fr; asm volatile("" : "+v"(fr_));
        const int row0 = u.pm * 256 + wr * 64 + fr_, col0 = u.pn * 256 + wc * 32 + 8 * fq;
#pragma unroll
        for (int ai = 0; ai < 2; ++ai)
#pragma unroll
            for (int mp = 0; mp < 2; ++mp) { u32x4 ga[2][2], gb[2][2];
#pragma unroll
                for (int mm = 0; mm < 2; ++mm)
#pragma unroll
                    for (int bj = 0; bj < 2; ++bj) { const size_t off = (size_t)(row0 + ai * 128 + (2 * mp + mm) * 16) * 1024 + col0 + bj * 128; ga[mm][bj] = __builtin_nontemporal_load((const u32x4*)(sga + off)); gb[mm][bj] = *(const u32x4*)(sgb + off); }
#pragma unroll
                for (int mm = 0; mm < 2; ++mm)
#pragma unroll
                    for (int bj = 0; bj < 2; ++bj) { const u32x4 a_ = ga[mm][bj], b_ = gb[mm][bj]; f32x4 r0, r1;
                        r0[0] = bf_lo(a_.x) * rc(bf_lo(b_.x)); r0[1] = bf_hi(a_.x) * rc(bf_hi(b_.x)); r0[2] = bf_lo(a_.y) * rc(bf_lo(b_.y)); r0[3] = bf_hi(a_.y) * rc(bf_hi(b_.y));
                        r1[0] = bf_lo(a_.z) * rc(bf_lo(b_.z)); r1[1] = bf_hi(a_.z) * rc(bf_hi(b_.z)); r1[2] = bf_lo(a_.w) * rc(bf_lo(b_.w)); r1[3] = bf_hi(a_.w) * rc(bf_hi(b_.w));
                        acc[ai][bj][2 * mp + mm][0] *= r0; acc[ai][bj][2 * mp + mm][1] *= r1; }
                asm volatile("" ::: "memory"); }
    }
    __device__ __forceinline__ void operator()(const f32x4 (&acc)[2][2][4][2], const Unit& u, int wr, int wc, int fr, int fq) const {
        const int row0 = u.pm * 256 + wr * 64 + fr, col0 = u.pn * 256 + wc * 32 + 8 * fq;
#pragma unroll
        for (int ai = 0; ai < 2; ++ai) { u32x4 g[4][2];
#pragma unroll
            for (int m = 0; m < 4; ++m)
#pragma unroll
                for (int bj = 0; bj < 2; ++bj) g[m][bj] = __builtin_nontemporal_load((const u32x4*)(sgb + (size_t)(row0 + ai * 128 + m * 16) * 1024 + col0 + bj * 128));
#pragma unroll
            for (int m = 0; m < 4; ++m)
#pragma unroll
                for (int bj = 0; bj < 2; ++bj) { const u32x4 b_ = g[m][bj]; const f32x4 v0 = acc[ai][bj][m][0], v1 = acc[ai][bj][m][1];
                    u32x4 w; w.x = pk2(cl(bf_lo(b_.x)) * v0[0], cl(bf_hi(b_.x)) * v0[1]); w.y = pk2(cl(bf_lo(b_.y)) * v0[2], cl(bf_hi(b_.y)) * v0[3]);
                    w.z = pk2(cl(bf_lo(b_.z)) * v1[0], cl(bf_hi(b_.z)) * v1[1]); w.w = pk2(cl(bf_lo(b_.w)) * v1[2], cl(bf_hi(b_.w)) * v1[3]);
                    ST_EPI(u.last, w, (u32x4*)(dst + (size_t)(row0 + ai * 128 + m * 16) * 1024 + col0 + bj * 128)); }
            asm volatile("" ::: "memory"); }
    }
};
struct EpiResid {
    static constexpr bool PERM = false, AFTER_DRAIN = false; static constexpr int MID_T = -1;
    const float* base; float* out; const float* gate;
    __device__ __forceinline__ void operator()(const f32x4 (&acc)[2][2][4][2], const Unit& u, int wr, int wc, int fr, int fq) const {
        const int row0 = u.pm * 256 + wr * 64 + fr, col0 = u.pn * 256 + wc * 32 + 4 * fq; const float* gp = gate + (size_t)(u.pm >> 4) * 6144 + col0;
        f32x4 gv[2][2];
#pragma unroll
        for (int bj = 0; bj < 2; ++bj)
#pragma unroll
            for (int n = 0; n < 2; ++n) gv[bj][n] = *(const f32x4*)(gp + bj * 128 + n * 16);
#pragma unroll
        for (int ai = 0; ai < 2; ++ai)
#pragma unroll
            for (int mp = 0; mp < 2; ++mp) { f32x4 bs[2][2][2];
#pragma unroll
                for (int mm = 0; mm < 2; ++mm)
#pragma unroll
                    for (int bj = 0; bj < 2; ++bj)
#pragma unroll
                        for (int n = 0; n < 2; ++n) bs[mm][bj][n] = __builtin_nontemporal_load((const f32x4*)(base + (size_t)(row0 + ai * 128 + (2 * mp + mm) * 16) * 1024 + col0 + bj * 128 + n * 16));
#pragma unroll
                for (int mm = 0; mm < 2; ++mm)
#pragma unroll
                    for (int bj = 0; bj < 2; ++bj)
#pragma unroll
                        for (int n = 0; n < 2; ++n) { const f32x4 o_ = bs[mm][bj][n] + gv[bj][n] * acc[ai][bj][2 * mp + mm][n]; ST_EPI(u.last, o_, (f32x4*)(out + (size_t)(row0 + ai * 128 + (2 * mp + mm) * 16) * 1024 + col0 + bj * 128 + n * 16)); }
                asm volatile("" ::: "memory"); }
    }
};
struct EpiSwiglu {
    static constexpr bool PERM = true, AFTER_DRAIN = false; static constexpr int MID_T = -1;
    bf16_t* act;
    __device__ __forceinline__ void operator()(const f32x4 (&acc)[2][2][4][2], const Unit& u, int wr, int wc, int fr, int fq) const {
        const int row0 = u.pm * 256 + wr * 64 + fr, col0 = u.pn * 128 + wc * 32 + 8 * fq;
#pragma unroll
        for (int ai = 0; ai < 2; ++ai)
#pragma unroll
            for (int m = 0; m < 4; ++m) { float r[8];
#pragma unroll
                for (int n = 0; n < 2; ++n)
#pragma unroll
                    for (int j = 0; j < 4; ++j) { const float g = acc[ai][0][m][n][j], uu = acc[ai][1][m][n][j]; r[4 * n + j] = g * fast_sigmoid(g) * uu; }
                u32x4 w; w.x = pk2(r[0], r[1]); w.y = pk2(r[2], r[3]); w.z = pk2(r[4], r[5]); w.w = pk2(r[6], r[7]);
                ST_EPI(u.last, w, (u32x4*)(act + (size_t)(row0 + ai * 128 + m * 16) * FFH + col0)); }
    }
};

__device__ __forceinline__ float wave_sum(float v) {
#pragma unroll
    for (int o = 1; o < 64; o <<= 1) v += __shfl_xor(v, o);
    return v;
}
template <bool FFN> __device__ __forceinline__ void transpose_item(const float* W, int K, int N, bf16_t* WT, int ldd, int koff, LAS float* scr, int item, int lane) {
    const int nblk = N / 32, kb = item / nblk, nb = item % nblk, k0 = 64 * kb, n0 = 32 * nb;
#pragma unroll
    for (int i = 0; i < 32; ++i) { const int kk = 2 * i + (lane >> 5); scr[kk * 33 + (lane & 31)] = W[(size_t)(k0 + kk) * N + n0 + (lane & 31)]; }
    LDS_WAIT();
    const int c = lane & 7;
#pragma unroll
    for (int j = 0; j < 4; ++j) { const int n = (lane >> 3) + 8 * j; const LAS float* s = scr + (8 * c) * 33 + n;
        u32x4 o; o.x = pk2(s[0 * 33], s[1 * 33]); o.y = pk2(s[2 * 33], s[3 * 33]); o.z = pk2(s[4 * 33], s[5 * 33]); o.w = pk2(s[6 * 33], s[7 * 33]);
        int row = n0 + n;
        if (FFN) { const int isu = row >= FFH ? 1 : 0, hid = row - isu * FFH; row = (hid >> 7) * 256 + isu * 128 + (hid & 127); }
        *(u32x4*)(WT + (size_t)row * ldd + koff + k0 + 8 * c) = o; }
    LDS_WAIT();
}
__device__ __forceinline__ void adaln_item(const float* c, const float* w_ada, const float* b_ada, float* mod, int item, LAS unsigned char* lds, int tid) {
    LAS float* cact = (LAS float*)lds;
    LAS float* red = (LAS float*)(lds + 32768);
    for (int i = tid; i < 8192; i += 512) { const int b = i >> 10, k = i & 1023; const float x = c[i]; cact[k * 8 + b] = x / (1.0f + expf(-x)); }
    __syncthreads();
    const int col = tid & 31, ks = tid >> 5, n = item * 32 + col;
    float acc[8];
#pragma unroll
    for (int b = 0; b < 8; ++b) acc[b] = 0.f;
#pragma unroll 32
    for (int kk = 0; kk < 64; ++kk) { const int k = ks * 64 + kk; const float w = w_ada[(size_t)k * 6144 + n];
        const f32x4 c0 = *(const LAS f32x4*)(cact + k * 8), c1 = *(const LAS f32x4*)(cact + k * 8 + 4);
        acc[0] += c0[0] * w; acc[1] += c0[1] * w; acc[2] += c0[2] * w; acc[3] += c0[3] * w; acc[4] += c1[0] * w; acc[5] += c1[1] * w; acc[6] += c1[2] * w; acc[7] += c1[3] * w; }
#pragma unroll
    for (int b = 0; b < 8; ++b) red[(ks * 8 + b) * 32 + col] = acc[b];
    __syncthreads();
    if (tid < 256) { const int b = tid >> 5, cc = tid & 31; float s = 0.f;
#pragma unroll
        for (int k2 = 0; k2 < 16; ++k2) s += red[(k2 * 8 + b) * 32 + cc];
        mod[b * 6144 + item * 32 + cc] = s + b_ada[item * 32 + cc]; }
    __syncthreads();
}
__device__ __forceinline__ void norm_rows(const float* src, const float* g, const float* shift, const float* scale, bf16_t* dst, int gw, int ngw, int lane) {
    f32x4 gv[4];
#pragma unroll
    for (int j = 0; j < 4; ++j) gv[j] = *((const f32x4*)g + 64 * j + lane);
    f32x4 v[4];
    if (gw < MTOK) {
#pragma unroll
        for (int j = 0; j < 4; ++j) v[j] = __builtin_nontemporal_load((const f32x4*)(src + (size_t)gw * D_) + lane + 64 * j);
    }
    for (int m = gw; m < MTOK; m += ngw) {
        const int b = m >> 12, mn = (m + ngw < MTOK) ? m + ngw : m;
        f32x4 vn[4], scv[4], shv[4];
        const f32x4* xn = (const f32x4*)(src + (size_t)mn * D_) + lane;
        const f32x4* sh = (const f32x4*)(shift + (size_t)b * 6144) + lane; const f32x4* sc = (const f32x4*)(scale + (size_t)b * 6144) + lane;
#pragma unroll
        for (int j = 0; j < 4; ++j) { scv[j] = sc[64 * j]; shv[j] = sh[64 * j]; }
#pragma unroll
        for (int j = 0; j < 4; ++j) vn[j] = __builtin_nontemporal_load(xn + 64 * j);
        float s = 0.f;
#pragma unroll
        for (int j = 0; j < 4; ++j) s += (v[j][0] * v[j][0] + v[j][1] * v[j][1]) + (v[j][2] * v[j][2] + v[j][3] * v[j][3]);
        const float rstd = rsqrtf(wave_sum(s) * (1.0f / D_) + EPS_);
        u32x2* o = (u32x2*)(dst + (size_t)m * D_) + lane;
#pragma unroll
        for (int j = 0; j < 4; ++j) { const f32x4 y = v[j] * rstd * gv[j] * (scv[j] + 1.0f) + shv[j]; u32x2 w; w.x = pk2(y[0], y[1]); w.y = pk2(y[2], y[3]); o[64 * j] = w; }
#pragma unroll
        for (int j = 0; j < 4; ++j) v[j] = vn[j];
    }
}

__device__ __forceinline__ void lru_item(const bf16_t* XR, bf16_t* GR, const float* conv_w, const float* conv_b, const float* w_rg, const float* b_rg,
                                         const float* w_ig, const float* b_ig, const float* lam_p, int item, LAS unsigned char* lds, int tid_in, int dummy) {
    int tid = tid_in; asm volatile("" : "+v"(tid));
    const int wave = __builtin_amdgcn_readfirstlane(tid >> 6), lane = tid & 63;
    const int b = item / 24, cgp = item % 24, blk = cgp >> 1, half = cgp & 1, c0 = blk * 128, oc0 = c0 + half * 64;
    LAS f32x2* TS = (LAS f32x2*)(lds + 69632);
    LAS float* CARRY = (LAS float*)(lds + 69632 + 4096);
    const int mt = wave >> 1, nt = wave & 1, r = lane & 31, hh = lane >> 5;
    bf16x8 Brg[8], Big[8];
    {
        const float* wr_ = w_rg + (size_t)blk * 16384 + half * 64 + 32 * nt + r; const float* wi_ = w_ig + (size_t)blk * 16384 + half * 64 + 32 * nt + r;
#pragma unroll
        for (int s = 0; s < 8; ++s) { float t[8], t2[8];
#pragma unroll
            for (int j = 0; j < 8; ++j) { t[j] = wr_[(16 * s + 8 * hh + j) * 128]; t2[j] = wi_[(16 * s + 8 * hh + j) * 128]; }
            u32x4 p; p.x = pk2(t[0], t[1]); p.y = pk2(t[2], t[3]); p.z = pk2(t[4], t[5]); p.w = pk2(t[6], t[7]); Brg[s] = __builtin_bit_cast(bf16x8, p);
            u32x4 p2; p2.x = pk2(t2[0], t2[1]); p2.y = pk2(t2[2], t2[3]); p2.z = pk2(t2[4], t2[5]); p2.w = pk2(t2[6], t2[7]); Big[s] = __builtin_bit_cast(bf16x8, p2); }
    }
    const float L2E = 1.4426950408889634f;
    const int chl = 32 * nt + r, och = oc0 + chl;
    const float brg = -b_rg[och] * L2E, big = -b_ig[och] * L2E;
    const float nsp = -8.0f * log1pf(expf(-lam_p[och]));
    const float nsp2 = nsp * L2E, nspx = 2.0f * nsp;
    const int cp2 = 2 * lane;
    float cw0[4], cw1[4];
#pragma unroll
    for (int k = 0; k < 4; ++k) { const f32x2 w2 = *(const f32x2*)(conv_w + k * LW + c0 + cp2); cw0[k] = w2[0]; cw1[k] = w2[1]; }
    const f32x2 cb2 = *(const f32x2*)(conv_b + c0 + cp2);
    if (tid < 128) CARRY[tid] = 0.f;
    const bf16_t* xsrc = XR + (size_t)b * SEQ_ * LW + c0 + cp2;
    unsigned xv[19];
    unsigned short gg[16];
#pragma unroll
    for (int j = 0; j < 19; ++j) { const int ts = 16 * wave - 3 + j; const int tsc = ts < 0 ? 0 : ts; const unsigned v = *(const unsigned*)(xsrc + (size_t)tsc * LW); xv[j] = ts < 0 ? 0u : v; }
#define LRU_CONV(XCW) do { _Pragma("unroll") for (int i = 0; i < 16; ++i) { float o0 = cb2[0], o1 = cb2[1]; \
        _Pragma("unroll") for (int k = 0; k < 4; ++k) { o0 += cw0[k] * bf_lo(xv[i + k]); o1 += cw1[k] * bf_hi(xv[i + k]); } \
        *(LAS unsigned*)((XCW) + (16 * wave + i) * 272 + lane * 4) = pk2(o0, o1); } } while (0)
#define LRU_LOADS(c) do { const int c_ = (c); bf16_t* gb_ = GR + ((size_t)b * SEQ_ + c_ * 128 + 32 * mt + 4 * hh) * CATLD + och; \
        _Pragma("unroll") for (int i = 0; i < 16; ++i) gg[i] = gb_[(size_t)((i & 3) + 8 * (i >> 2)) * CATLD]; \
        const int tn_ = (c_ < 31 ? c_ + 1 : c_) * 128 + 16 * wave - 3; \
        _Pragma("unroll") for (int j = 0; j < 19; ++j) xv[j] = *(const unsigned*)(xsrc + (size_t)(tn_ + j) * LW); } while (0)
    LRU_CONV(lds);
    LRU_LOADS(0);
    __syncthreads();
    for (int chn = 0; chn < 32; ++chn) {
        bf16_t* gbase = GR + ((size_t)b * SEQ_ + chn * 128 + 32 * mt + 4 * hh) * CATLD + och;
        LAS unsigned char* XC = lds + (chn & 1) * 34816; LAS unsigned char* XCN = lds + ((chn + 1) & 1) * 34816; LAS f32x2* TSp = TS + (chn & 1) * 256;
        f32x16 aR, aI;
#pragma unroll
        for (int i = 0; i < 16; ++i) { aR[i] = 0.f; aI[i] = 0.f; }
        bf16x8 af[8];
#pragma unroll
        for (int s = 0; s < 8; ++s) af[s] = *(const LAS bf16x8*)(XC + (32 * mt + r) * 272 + (16 * s + 8 * hh) * 2);
        __builtin_amdgcn_sched_barrier(0);
#pragma unroll
        for (int s = 0; s < 8; ++s) { aR = MFMA32(af[s], Brg[s], aR); aI = MFMA32(af[s], Big[s], aI); }
#pragma unroll
        for (int i = 0; i < 16; ++i) { const int tok = 32 * mt + (i & 3) + 8 * (i >> 2) + 4 * hh;
            const float rr = __builtin_amdgcn_rcpf(1.0f + __builtin_amdgcn_exp2f(brg - aR[i] * L2E)), ii = __builtin_amdgcn_rcpf(1.0f + __builtin_amdgcn_exp2f(big - aI[i] * L2E));
            const float av = __builtin_amdgcn_exp2f(nsp2 * rr), x2 = nspx * rr;
            const float ty = -x2 * (1.0f + x2 * 0.5f * (1.0f + x2 * (1.0f / 3.0f) * (1.0f + x2 * 0.25f * (1.0f + x2 * 0.2f * (1.0f + x2 * (1.0f / 6.0f))))));
            const float m2 = x2 > -0.25f ? ty : 1.0f - av * av;
            const float xcv = bf1(*(const LAS unsigned short*)(XC + tok * 272 + (half * 64 + chl) * 2));
            aR[i] = av; aI[i] = __builtin_amdgcn_sqrtf(m2) * (ii * xcv); }
        float Ag[4], hg[4], Agp[4], hgp[4];
#pragma unroll
        for (int g = 0; g < 4; ++g) { float h = aI[4 * g], A = aR[4 * g];
#pragma unroll
            for (int e = 1; e < 4; ++e) { h = aR[4 * g + e] * h + aI[4 * g + e]; A *= aR[4 * g + e]; aI[4 * g + e] = h; aR[4 * g + e] = A; }
            Ag[g] = A; hg[g] = h; Agp[g] = xor32(A); hgp[g] = xor32(h); }
        float PA[4], Ph[4]; float TA = 1.0f, Th = 0.0f;
#pragma unroll
        for (int g = 0; g < 4; ++g) { const float EA = hh ? Agp[g] : Ag[g], Eh = hh ? hgp[g] : hg[g], OA = hh ? Ag[g] : Agp[g], Oh = hh ? hg[g] : hgp[g];
            const float pA0 = TA, ph0 = Th; Th = EA * Th + Eh; TA *= EA;
            PA[g] = hh ? TA : pA0; Ph[g] = hh ? Th : ph0; Th = OA * Th + Oh; TA *= OA; }
        if (hh == 0) TSp[mt * 64 + chl] = (f32x2){TA, Th};
        if (chn < 31) LRU_CONV(XCN);
        __syncthreads();
        float cin = CARRY[(chn & 1) * 64 + chl];
        for (int m2 = 0; m2 < mt; ++m2) { const f32x2 t = TSp[m2 * 64 + chl]; cin = t[0] * cin + t[1]; }
        if (mt == 3 && hh == 0) CARRY[((chn + 1) & 1) * 64 + chl] = TA * cin + Th;
#pragma unroll
        for (int g = 0; g < 4; ++g) { const float cg_ = PA[g] * cin + Ph[g];
#pragma unroll
            for (int e = 0; e < 4; ++e) { const int i = 4 * g + e; const float y = (aI[i] + aR[i] * cg_) * bf1(gg[i]);
                gbase[(size_t)((i & 3) + 8 * (i >> 2)) * CATLD] = dummy ? gg[i] : (unsigned short)(pk2(y, 0.f) & 0xffffu); } }
        if (chn < 31) LRU_LOADS(chn + 1);
    }
#undef LRU_CONV
#undef LRU_LOADS
    __syncthreads();
}

__device__ __forceinline__ void attn_strip(const bf16_t* Q, const bf16_t* Kp, const bf16_t* Vp, bf16_t* O, int sidx, LAS unsigned char* vl, int lane) {
    const int qs = sidx & 127, hd = (sidx >> 7) & 7, b = sidx >> 10;
    const int r = lane & 31, hh = lane >> 5;
    const size_t tok0 = (size_t)b * SEQ_;
    bf16x8 qf[8];
    { const bf16_t* qrow = Q + (tok0 + 32 * qs + r) * CATLD + hd * 128 + 8 * hh;
#pragma unroll
      for (int s = 0; s < 8; ++s) qf[s] = *(const bf16x8*)(qrow + 16 * s); }
    f32x16 oacc[4];
#pragma unroll
    for (int c4 = 0; c4 < 4; ++c4)
#pragma unroll
        for (int i = 0; i < 16; ++i) oacc[c4][i] = 0.f;
    float crun = 0.f;
    const int vrow = lane >> 4, vch = lane & 15;
    const int q4 = (lane & 15) >> 2, p4 = lane & 3, blk = (lane >> 4) & 1;
    LAS unsigned char* trp = vl + (4 * hh + q4) * 320 + (16 * blk + 4 * p4) * 2;
    const bf16_t* kbase = Kp + (tok0 + vrow) * 1024 + hd * 128 + vch * 8;
    const bf16_t* vbase = Vp + (tok0 + vrow) * 1024 + hd * 128 + vch * 8;
    u32x4 kk[8], vv[8];
    LAS unsigned char* kl = vl + 10240;
#define ATT_LOAD(kt_) do { const size_t ko_ = (size_t)(kt_) * 32 * 1024; \
        _Pragma("unroll") for (int i = 0; i < 8; ++i) kk[i] = *(const u32x4*)(kbase + ko_ + (size_t)i * 4096); \
        _Pragma("unroll") for (int i = 0; i < 8; ++i) vv[i] = *(const u32x4*)(vbase + ko_ + (size_t)i * 4096); } while (0)
    ATT_LOAD(qs);
    for (int kt = qs; kt >= 0; --kt) {
#pragma unroll
        for (int i = 0; i < 8; ++i) *(LAS u32x4*)(kl + (vrow + 4 * i) * 272 + vch * 16) = kk[i];
#pragma unroll
        for (int i = 0; i < 8; ++i) *(LAS u32x4*)(vl + (vrow + 4 * i) * 320 + vch * 16) = vv[i];
        LDS_WAIT();
        f32x16 x, x1;
#pragma unroll
        for (int i = 0; i < 16; ++i) { x[i] = 0.f; x1[i] = 0.f; }
#pragma unroll
        for (int s = 0; s < 8; s += 2) { const bf16x8 kf0 = *(const LAS bf16x8*)(kl + r * 272 + (16 * s + 8 * hh) * 2), kf1 = *(const LAS bf16x8*)(kl + r * 272 + (16 * s + 16 + 8 * hh) * 2);
            x = MFMA32(kf0, qf[s], x); x1 = MFMA32(kf1, qf[s + 1], x1); }
#pragma unroll
        for (int i = 0; i < 16; ++i) x[i] += x1[i];
        { const int kn = kt > 0 ? kt - 1 : 0; ATT_LOAD(kn); }
        const bool diag = (kt == qs);
        float lomb[16];
#pragma unroll
        for (int i = 0; i < 16; ++i) { const float z = x[i]; const float e = __builtin_amdgcn_exp2f(-fabsf(z));
            const float sp = fmaxf(z, 0.f) + __builtin_amdgcn_logf(1.0f + e);
            const bool valid = !diag || ((i & 3) + 8 * (i >> 2) + 4 * hh) < r;
            lomb[i] = valid ? -sp : 0.f; }
        float G[4], Gp[4], T[4], hp[4];
#pragma unroll
        for (int g = 0; g < 4; ++g) { G[g] = (lomb[4 * g] + lomb[4 * g + 1]) + (lomb[4 * g + 2] + lomb[4 * g + 3]); Gp[g] = xor32(G[g]); T[g] = G[g] + Gp[g]; hp[g] = hh == 0 ? Gp[g] : 0.f; }
        float after[4];
        after[3] = hp[3]; after[2] = T[3] + hp[2]; after[1] = (T[3] + T[2]) + hp[1]; after[0] = ((T[3] + T[2]) + T[1]) + hp[0];
#pragma unroll
        for (int g = 0; g < 4; ++g) { const float base = crun + after[g];
            const float s3 = 0.f, s2 = lomb[4 * g + 3], s1 = s2 + lomb[4 * g + 2], s0 = s1 + lomb[4 * g + 1];
            const float sf[4] = {s0, s1, s2, s3};
#pragma unroll
            for (int e = 0; e < 4; ++e) { const int i = 4 * g + e; const bool valid = !diag || ((8 * g + 4 * hh + e) < r);
                const float wv = __builtin_amdgcn_exp2f((x[i] + lomb[i]) + (base + sf[e])); x[i] = valid ? wv : 0.f; } }
        crun += ((T[3] + T[2]) + T[1]) + T[0];
        bf16x8 wf[2];
#pragma unroll
        for (int s = 0; s < 2; ++s) { u32x4 p; p.x = pk2(x[8 * s], x[8 * s + 1]); p.y = pk2(x[8 * s + 2], x[8 * s + 3]); p.z = pk2(x[8 * s + 4], x[8 * s + 5]); p.w = pk2(x[8 * s + 6], x[8 * s + 7]); wf[s] = __builtin_bit_cast(bf16x8, p); }
        LDS_WAIT();
        bf16x8 va[2][4];
#pragma unroll
        for (int s = 0; s < 2; ++s)
#pragma unroll
            for (int c4 = 0; c4 < 4; ++c4) {
                const s16x4 lo = __builtin_amdgcn_ds_read_tr16_b64_v4i16((LAS s16x4*)(trp + (16 * s) * 320 + 64 * c4));
                const s16x4 hi = __builtin_amdgcn_ds_read_tr16_b64_v4i16((LAS s16x4*)(trp + (16 * s + 8) * 320 + 64 * c4));
                va[s][c4] = __builtin_shufflevector(lo, hi, 0, 1, 2, 3, 4, 5, 6, 7); }
        __builtin_amdgcn_sched_barrier(0);
#pragma unroll
        for (int s = 0; s < 2; ++s)
#pragma unroll
            for (int c4 = 0; c4 < 4; ++c4) oacc[c4] = MFMA32(va[s][c4], wf[s], oacc[c4]);
        LDS_WAIT();
        if (__ballot(crun < -151.5f) == ~0ull) break;
    }
#undef ATT_LOAD
    bf16_t* orow = O + (tok0 + 32 * qs + r) * CATLD + hd * 128 + 4 * hh;
#pragma unroll
    for (int c4 = 0; c4 < 4; ++c4)
#pragma unroll
        for (int g = 0; g < 4; ++g) { u32x2 w; w.x = pk2(oacc[c4][4 * g], oacc[c4][4 * g + 1]); w.y = pk2(oacc[c4][4 * g + 2], oacc[c4][4 * g + 3]); *(u32x2*)(orow + 32 * c4 + 8 * g) = w; }
}


__device__ __forceinline__ void stagger_start(int bx, int slots) {
    const int n = (bx & 7) * slots;
    for (int i = 0; i < n; ++i) __builtin_amdgcn_s_sleep(20);
    __syncthreads();
}

#define XB_TMO      128
#define XB_XCNT(j)  (256  + 64 * (j))
#define XB_XSUB(j)  (1280 + 64 * (j))
#define XB_XGEN(j)  (2304 + 64 * (j))
#define XB_TOP      3328
#define XB_TOPGEN   3392
#define XCD_BAR_WORDS 3456
#define XB_SPIN_CAP (1u << 18)

__device__ __forceinline__ unsigned xb_ld(unsigned* p)              { return __hip_atomic_load(p, __ATOMIC_RELAXED, __HIP_MEMORY_SCOPE_AGENT); }
__device__ __forceinline__ unsigned xb_add(unsigned* p, unsigned v) { return __hip_atomic_fetch_add(p, v, __ATOMIC_RELAXED, __HIP_MEMORY_SCOPE_AGENT); }
__device__ __forceinline__ unsigned xb_xcc_id() { return (unsigned)__builtin_amdgcn_s_getreg((3 << 11) | 20) & 0xFu; }
#define XB_SPIN(cond, bar) do { unsigned _sp = 0; while (cond) { __builtin_amdgcn_s_sleep(1); \
    if ((++_sp & 255u) == 0u) { if (xb_ld(&(bar)[XB_TMO])) break; if (_sp > XB_SPIN_CAP) { atomicAdd(&(bar)[XB_TMO], 1u); break; } } } } while (0)

struct XcdBarrier {
    unsigned* bar; unsigned x;
    volatile LAS unsigned* st;
};

__device__ __forceinline__ XcdBarrier xcd_barrier_post(unsigned* bar, volatile LAS unsigned* st) {
    XcdBarrier b; b.bar = bar; b.x = xb_xcc_id(); b.st = st;
    if (threadIdx.x == 0) (void)xb_add(&bar[XB_XCNT(b.x)], 1u);
    return b;
}
__device__ __forceinline__ void xcd_barrier_complete(unsigned* bar, unsigned x, unsigned& nloc, unsigned& nx) {
    const unsigned G = gridDim.x * gridDim.y * gridDim.z;
    unsigned sum, cnt, mine, sp = 0u;
    for (;;) {
        sum = 0u; cnt = 0u; mine = 0u;
#pragma unroll
        for (unsigned j = 0; j < 16; ++j) { const unsigned c = xb_ld(&bar[XB_XCNT(j)]); sum += c; cnt += (c > 0u) ? 1u : 0u; mine = (j == x) ? c : mine; }
        if (sum == G) break;
        __builtin_amdgcn_s_sleep(1);
        if ((++sp & 255u) == 0u) { if (xb_ld(&bar[XB_TMO])) break; if (sp > XB_SPIN_CAP) { atomicAdd(&bar[XB_TMO], 1u); break; } }
    }
    nloc = mine > 0u ? mine : 1u; nx = cnt > 0u ? cnt : 1u;
}

__device__ __forceinline__ void xcd_barrier(const XcdBarrier& b) {
    asm volatile("s_waitcnt vmcnt(0)" ::: "memory");
    __syncthreads();
    if (threadIdx.x == 0) {
        unsigned* bar = b.bar;
        __builtin_amdgcn_s_waitcnt(0);
        unsigned nloc = b.st[0], nx = b.st[1];
        if (nloc == 0u) { xcd_barrier_complete(bar, b.x, nloc, nx); b.st[0] = nloc; b.st[1] = nx; }
        const unsigned old = xb_add(&bar[XB_XSUB(b.x)], 1u);
        const unsigned gen = old / nloc;
        if (old + 1u == (gen + 1u) * nloc) {
            __builtin_amdgcn_fence(__ATOMIC_RELEASE, "agent");
            asm volatile("s_waitcnt vmcnt(0)" ::: "memory");
            const unsigned og = xb_add(&bar[XB_TOP], 1u);
            const unsigned tg = og / nx;
            if (og + 1u == (tg + 1u) * nx) xb_add(&bar[XB_TOPGEN], 1u);
            else XB_SPIN(xb_ld(&bar[XB_TOPGEN]) == tg, bar);
            __builtin_amdgcn_fence(__ATOMIC_ACQUIRE, "agent");
            xb_add(&bar[XB_XGEN(b.x)], 1u);
            asm volatile("s_waitcnt vmcnt(0)" ::: "memory");
        } else {
            XB_SPIN(xb_ld(&bar[XB_XGEN(b.x)]) == gen, bar);
            __builtin_amdgcn_fence(__ATOMIC_ACQUIRE, "agent");
            asm volatile("s_waitcnt vmcnt(0)" ::: "memory");
        }
    }
    __syncthreads();
}

struct Args { const float* in[21]; float* out; unsigned char* ws; int ph_lo, ph_hi; };
__global__ void __launch_bounds__(512, 2) fwd_kernel(Args a) {
    extern __shared__ __attribute__((aligned(16))) unsigned char lds_[];
    LAS unsigned char* lds = (LAS unsigned char*)lds_;
    cg::grid_group grid = cg::this_grid();
    const int tid = threadIdx.x, lane = tid & 63, wave = __builtin_amdgcn_readfirstlane(tid >> 6);
    const int G = gridDim.x, bx = blockIdx.x, gw = bx * 8 + wave, ngw = G * 8;
    unsigned char* ws = a.ws;
    bf16_t* Qb = (bf16_t*)(ws + WS_CAT); bf16_t* Kb = (bf16_t*)(ws + WS_K); bf16_t* Vb = (bf16_t*)(ws + WS_V); bf16_t* XRb = (bf16_t*)(ws + WS_XR); bf16_t* GRb = Qb + 1024;
    bf16_t* Hb = (bf16_t*)(ws + WS_H); bf16_t* MRGb = (bf16_t*)(ws + WS_MERGED); bf16_t* ACTb = (bf16_t*)(ws + WS_ACT);
    bf16_t* Win = (bf16_t*)(ws + WS_WIN); bf16_t* Wcat = (bf16_t*)(ws + WS_WCAT); bf16_t* Wout = (bf16_t*)(ws + WS_WOUT);
    bf16_t* Wf1 = (bf16_t*)(ws + WS_WF1); bf16_t* Wf2 = (bf16_t*)(ws + WS_WF2);
    float* mod = (float*)(ws + WS_MOD); unsigned* ctl = (unsigned*)(ws + WS_CTL);
    bf16_t* SGA = (bf16_t*)a.out; bf16_t* SGB = (bf16_t*)a.out + (size_t)MTOK * 1024;
    const float* x = a.in[0];

#define IN(k) (a.ph_lo <= (k) && (k) < a.ph_hi)
#define SEAM(k) do { if (IN(k) && IN((k) + 1)) { if (a.ph_hi > NPHASE) grid.sync(); else xcd_barrier(xbar); } } while (0)
    XcdBarrier xbar; xbar.bar = ctl + 1024; xbar.x = 0; xbar.st = (volatile LAS unsigned*)(lds + 8 * 18944 + 32);
    if (a.ph_hi - a.ph_lo > 1) { if (tid == 0) { xbar.st[0] = 0u; xbar.st[1] = 0u; } __syncthreads(); xbar = xcd_barrier_post(ctl + 1024, (volatile LAS unsigned*)(lds + 8 * 18944 + 32)); }
    {
        if (IN(0)) {
            for (int it = bx; it < 192; it += G) adaln_item(a.in[1], a.in[2], a.in[3], mod, it, lds, tid);
            LAS float* scr = (LAS float*)(lds + wave * 8448);
            constexpr int I_IN = 16 * 256, I_PA = 16 * 32, I_PL = 24 * 32, I_OUT = 16 * 32, I_F1 = 16 * 176, I_F2 = 44 * 32;
            constexpr int NIT = I_IN + I_PA + I_PL + I_OUT + I_F1 + I_F2;
            for (int it = gw; it < NIT; it += ngw) {
                int rr = it;
                if (rr < I_IN) { transpose_item<false>(a.in[5], 1024, NIN, Win, 1024, 0, scr, rr, lane); continue; } rr -= I_IN;
                if (rr < I_PA) { transpose_item<false>(a.in[15], 1024, 1024, Wcat, CATLD, 0, scr, rr, lane); continue; } rr -= I_PA;
                if (rr < I_PL) { transpose_item<false>(a.in[16], LW, 1024, Wcat, CATLD, 1024, scr, rr, lane); continue; } rr -= I_PL;
                if (rr < I_OUT) { transpose_item<false>(a.in[17], 1024, 1024, Wout, 1024, 0, scr, rr, lane); continue; } rr -= I_OUT;
                if (rr < I_F1) { transpose_item<true>(a.in[19], 1024, 2 * FFH, Wf1, 1024, 0, scr, rr, lane); continue; } rr -= I_F1;
                transpose_item<false>(a.in[20], FFH, 1024, Wf2, FFH, 0, scr, rr, lane);
            }
        }
        SEAM(0);
        if (IN(1)) {
            norm_rows(x, a.in[4], mod, mod + 1024, Hb, gw, ngw, lane);
        }
        SEAM(1);
        if (IN(2)) {
            stagger_start(bx, STAG_G1);
            pg8::Gemm g{Hb, Win, MTOK, NIN, 1024}; pg8::StaticOrder S; S.init(MTOK, NIN, G, bx);
            EpiIn E{Qb, Kb, Vb, XRb, SGA, SGB, a.in[6], a.in[7], (LAS float*)(lds + 131072)};
            pg8::gemm_phase<EpiIn, pg8::StaticOrder, GEMM_ALIGN, GEMM_SP2>(lds, g, S, E);
        }
        SEAM(2);
        if (IN(3)) {
            const int dummy = 0;
            for (int it = bx; it < 192; it += G) lru_item(XRb, GRb, a.in[8], a.in[9], a.in[10], a.in[11], a.in[12], a.in[13], a.in[14], it, lds, tid, dummy);
            int lane_o = lane; asm volatile("" : "+v"(lane_o));
            LAS unsigned char* vl = lds + wave * 18944;
            unsigned* cnt = ctl + 16 * dummy; bf16_t* Odst = dummy ? Hb : Qb;
            LAS unsigned* qword = (LAS unsigned*)(lds + 8 * 18944);
            for (;;) {
                __syncthreads();
                if (tid == 0) *qword = __hip_atomic_fetch_add(cnt, 8u, __ATOMIC_RELAXED, __HIP_MEMORY_SCOPE_AGENT);
                __syncthreads();
                const unsigned s = *qword + (unsigned)wave;
                if (s >= (unsigned)(NB * NH * 128)) break;
                attn_strip(Qb, Kb, Vb, Odst, (int)s, vl, lane_o);
            }
        }
        SEAM(3);
        if (IN(4)) {
            pg8::Gemm g{Qb, Wcat, MTOK, 1024, CATLD}; pg8::StaticOrder S; S.init(MTOK, 1024, G, bx);
            EpiMerge E{SGA, SGB, MRGb}; pg8::gemm_phase<EpiMerge, pg8::StaticOrder, GEMM_ALIGN, GEMM_SP2>(lds, g, S, E);
        }
        SEAM(4);
        if (IN(5)) {
            pg8::Gemm g{MRGb, Wout, MTOK, 1024, 1024}; pg8::StaticOrder S; S.init(MTOK, 1024, G, bx);
            EpiResid E{x, a.out, mod + 2 * 1024}; pg8::gemm_phase<EpiResid, pg8::StaticOrder, GEMM_ALIGN, GEMM_SP2>(lds, g, S, E);
        }
        SEAM(5);
        if (IN(6)) {
            norm_rows(a.out, a.in[18], mod + 3 * 1024, mod + 4 * 1024, Hb, gw, ngw, lane);
        }
        SEAM(6);
        if (IN(7)) {
            stagger_start(bx, STAG_G5);
            pg8::Gemm g{Hb, Wf1, MTOK, 2 * FFH, 1024}; pg8::StaticOrder S; S.init(MTOK, 2 * FFH, G, bx);
            EpiSwiglu E{ACTb}; pg8::gemm_phase<EpiSwiglu, pg8::StaticOrder, GEMM_ALIGN, GEMM_SP2>(lds, g, S, E);
        }
        SEAM(7);
        if (IN(8)) {
            pg8::Gemm g{ACTb, Wf2, MTOK, 1024, FFH}; pg8::StaticOrder S; S.init(MTOK, 1024, G, bx);
            EpiResid E{a.out, a.out, mod + 5 * 1024}; pg8::gemm_phase<EpiResid, pg8::StaticOrder, GEMM_ALIGN, GEMM_SP2>(lds, g, S, E);
        }
    }
#undef IN
#undef SEAM
}

extern "C" void kernel_launch(void* const* d_in, const int* in_sizes, int n_in, void* d_out, int out_size, void* d_ws, size_t ws_size, hipStream_t stream) {
    static int grid = 0;
    if (grid == 0) {
        if (n_in != 21 || in_sizes[0] != MTOK * D_ || out_size != MTOK * D_ || ws_size < WS_END) { fprintf(stderr, "kernel_launch: unexpected shapes / workspace (%d inputs, ws %zu < %zu)\n", n_in, ws_size, (size_t)WS_END); grid = -1; return; }
        int dev = 0, cus = 0, per_cu = 0;
        hipGetDevice(&dev); hipDeviceGetAttribute(&cus, hipDeviceAttributeMultiprocessorCount, dev);
        if (hipFuncSetAttribute((const void*)fwd_kernel, hipFuncAttributeMaxDynamicSharedMemorySize, LDS_BYTES) != hipSuccess) { fprintf(stderr, "kernel_launch: hipFuncSetAttribute failed\n"); grid = -1; return; }
        if (hipOccupancyMaxActiveBlocksPerMultiprocessor(&per_cu, (const void*)fwd_kernel, 512, LDS_BYTES) != hipSuccess || per_cu < 1) { fprintf(stderr, "kernel_launch: occupancy query says %d\n", per_cu); per_cu = 1; }
        (void)hipGetLastError();
        grid = cus > 0 ? cus : 256;
    }
    if (grid < 0) return;
    (void)hipMemsetAsync((char*)d_ws + WS_CTL, 0, 20480, stream);
    Args a{};
    for (int i = 0; i < 21; ++i) a.in[i] = (const float*)d_in[i];
    a.out = (float*)d_out; a.ws = (unsigned char*)d_ws;
#if MK_PER_PHASE
    for (int ph = 0; ph < NPHASE; ++ph) { a.ph_lo = ph; a.ph_hi = ph + 1; hipLaunchKernelGGL(fwd_kernel, dim3(grid), dim3(512), LDS_BYTES, stream, a); }
#else
    a.ph_lo = 0; a.ph_hi = NPHASE;
    void* args[] = {&a};
    hipError_t e = hipLaunchCooperativeKernel((void*)fwd_kernel, dim3(grid), dim3(512), args, LDS_BYTES, stream);
    if (e != hipSuccess) fprintf(stderr, "cooperative launch failed: %s (grid %d)\n", hipGetErrorString(e), grid);
#endif
}
```
